# Optimizing an MI355X kernel written in HIP

```python
import jax, jax.numpy as jnp
from jax import lax
import numpy as np

D_MODEL = 2048
BATCH = 2
SEQ = 8192
DEPTH = 1

HEAD_DIM = 64
N_HEADS_SWA = 16
N_KV_SWA = 4
N_HEADS_FOX = 16
WINDOW = 128
BLOCK = 128
SWA_WIDTH = N_HEADS_SWA * HEAD_DIM
KV_WIDTH = N_KV_SWA * HEAD_DIM
FOX_WIDTH = N_HEADS_FOX * HEAD_DIM
MIX_WIDTH = SWA_WIDTH + FOX_WIDTH
IN_COLS = SWA_WIDTH + 2 * KV_WIDTH + 3 * FOX_WIDTH + N_HEADS_FOX
N_GROUPS = 4
EXPERTS_PER_GROUP = 8
N_EXPERTS = N_GROUPS * EXPERTS_PER_GROUP
TOP_K = 2
D_EXPERT = 512
MOE_BLOCK = 128
EPS = 1e-6

kernel_name = "hymba_swa_sink_fox_hier_moe_adaln"


def rmsnorm(x, g):
    xf = x.astype(jnp.float32)
    y = xf * lax.rsqrt(jnp.mean(xf * xf, axis=-1, keepdims=True) + EPS)
    return (y * g.astype(jnp.float32)).astype(x.dtype)


def alibi_slopes(n):
    return jnp.asarray(2.0 ** (-8.0 * np.arange(1, n + 1) / n), dtype=jnp.float32)


def sliding_window_gqa(q, k, v, sinks):
    B, S, Hq, d = q.shape
    Hkv = k.shape[2]
    G = Hq // Hkv
    nb = S // BLOCK
    qb = q.reshape(B, nb, BLOCK, Hkv, G, d)

    def with_prev(t):
        tb = t.reshape(B, nb, BLOCK, Hkv, d)
        prev = jnp.pad(tb, ((0, 0), (1, 0), (0, 0), (0, 0), (0, 0)))[:, :-1]
        return jnp.concatenate([prev, tb], axis=2)

    kb, vb = with_prev(k), with_prev(v)
    scores = jnp.einsum('bnqhgd,bnkhd->bhgnqk', qb, kb).astype(jnp.float32) * (d ** -0.5)
    qpos = jnp.arange(BLOCK)[:, None] + BLOCK
    kpos = jnp.arange(2 * BLOCK)[None, :]
    dist = qpos - kpos
    in_band = (dist >= 0) & (dist < WINDOW)
    has_prev = (jnp.arange(nb)[:, None, None] > 0) | (kpos >= BLOCK)[None]
    mask = in_band[None] & has_prev
    slopes = alibi_slopes(Hq).reshape(Hkv, G, 1, 1, 1)
    scores = scores - slopes * dist.astype(jnp.float32)
    scores = jnp.where(mask, scores, -jnp.inf)
    sink = sinks.astype(jnp.float32).reshape(Hkv, G, 1, 1, 1)
    m = jnp.maximum(jnp.max(scores, axis=-1, keepdims=True), sink)
    p = jnp.exp(scores - m)
    p = p / (jnp.sum(p, axis=-1, keepdims=True) + jnp.exp(sink - m))
    out = jnp.einsum('bhgnqk,bnkhd->bnqhgd', p.astype(v.dtype), vb)
    return out.reshape(B, S, Hq * d)


def forgetting_attention(q, k, v, log_f):
    B, S, H, d = q.shape
    nb = S // BLOCK
    cum = lax.cumsum(log_f, axis=1).transpose(0, 2, 1)
    outs = []
    for i in range(nb):
        q0 = i * BLOCK
        kend = q0 + BLOCK
        s = jnp.einsum('bqhd,bkhd->bhqk', q[:, q0:kend], k[:, :kend]).astype(jnp.float32) * (d ** -0.5)
        s = s + cum[:, :, q0:kend, None] - cum[:, :, None, :kend]
        causal = (q0 + jnp.arange(BLOCK))[:, None] >= jnp.arange(kend)[None, :]
        p = jax.nn.softmax(jnp.where(causal, s, -jnp.inf), axis=-1)
        outs.append(jnp.einsum('bhqk,bkhd->bqhd', p.astype(v.dtype), v[:, :kend]))
    return jnp.concatenate(outs, axis=1).reshape(B, S, H * d)


def routed_expert_ffn(t, expert_id, weight, w_gate, w_up, w_down):
    N, D = t.shape
    A = expert_id.shape[0]
    tok = jnp.arange(A, dtype=jnp.int32) // TOP_K
    order = jnp.argsort(expert_id)
    se, stok, sw = expert_id[order], tok[order], weight[order]
    counts = jnp.bincount(expert_id, length=N_EXPERTS)
    starts = jnp.cumsum(counts) - counts
    padded = (counts + MOE_BLOCK - 1) // MOE_BLOCK * MOE_BLOCK
    pend = jnp.cumsum(padded)
    pstart = pend - padded
    dest = pstart[se] + jnp.arange(A) - starts[se]
    n_blocks = -(-A // MOE_BLOCK) + N_EXPERTS
    P = n_blocks * MOE_BLOCK
    row_tok = jnp.zeros((P,), jnp.int32).at[dest].set(stok)
    row_w = jnp.zeros((P,), t.dtype).at[dest].set(sw.astype(t.dtype))
    block_e = jnp.minimum(jnp.searchsorted(pend, jnp.arange(n_blocks) * MOE_BLOCK, side='right'), N_EXPERTS - 1)
    xb = t[row_tok].reshape(n_blocks, MOE_BLOCK, D)

    def expert_block(args):
        xblk, e = args
        hid = jax.nn.silu(xblk @ w_gate[e]) * (xblk @ w_up[e])
        return hid @ w_down[e]

    yb = lax.map(expert_block, (xb, block_e)).reshape(P, D)
    return jnp.zeros((N, D), t.dtype).at[row_tok].add(yb * row_w[:, None])


def hierarchical_moe(h, w_group, b_group, w_expert, b_expert, w_gate, w_up, w_down):
    B, S, D = h.shape
    N = B * S
    t = h.reshape(N, D)
    g_logits = (t @ w_group).astype(jnp.float32) + b_group.astype(jnp.float32)
    g_prob = jax.nn.softmax(g_logits, axis=-1)
    g_val, g_sel = lax.top_k(g_prob, 1)
    e_logits = ((t @ w_expert).astype(jnp.float32) + b_expert.astype(jnp.float32)).reshape(N, N_GROUPS, EXPERTS_PER_GROUP)
    e_in = jnp.take_along_axis(e_logits, g_sel[:, :, None], axis=1)[:, 0]
    top_val, top_idx = lax.top_k(e_in, TOP_K)
    gate = jax.nn.softmax(top_val, axis=-1) * g_val
    expert_id = (g_sel * EXPERTS_PER_GROUP + top_idx).astype(jnp.int32)
    y = routed_expert_ffn(t, expert_id.reshape(-1), gate.reshape(-1), w_gate, w_up, w_down)
    return y.reshape(B, S, D)


def setup_inputs(seed: int = 0) -> dict:
    key = jax.random.key(seed)
    ks = jax.random.split(key, 20)
    f32 = jnp.float32
    L, D = DEPTH, D_MODEL

    def nrm(k, shape, s):
        return s * jax.random.normal(k, shape, f32)

    return {
        "x": nrm(ks[0], (BATCH, SEQ, D), 1.0),
        "c": nrm(ks[1], (BATCH, D), 1.0),
        "w_ada": nrm(ks[2], (L, D, 6 * D), 0.5 * D ** -0.5),
        "b_ada": nrm(ks[3], (L, 6 * D), 0.01),
        "norm_mix_g": 1.0 + nrm(ks[4], (L, D), 0.05),
        "w_in": nrm(ks[5], (L, D, IN_COLS), D ** -0.5),
        "b_forget": 4.0 + nrm(ks[6], (L, N_HEADS_FOX), 0.5),
        "sinks": nrm(ks[7], (L, N_HEADS_SWA), 1.0),
        "out_norm_swa_g": 1.0 + nrm(ks[8], (L, SWA_WIDTH), 0.05),
        "out_norm_fox_g": 1.0 + nrm(ks[9], (L, FOX_WIDTH), 0.05),
        "w_out": nrm(ks[10], (L, MIX_WIDTH, D), MIX_WIDTH ** -0.5),
        "norm_moe_g": 1.0 + nrm(ks[11], (L, D), 0.05),
        "w_group": nrm(ks[12], (L, D, N_GROUPS), D ** -0.5),
        "b_group": nrm(ks[13], (L, N_GROUPS), 0.01),
        "w_expert": nrm(ks[14], (L, D, N_EXPERTS), D ** -0.5),
        "b_expert": nrm(ks[15], (L, N_EXPERTS), 0.01),
        "w_gate": nrm(ks[16], (L, N_EXPERTS, D, D_EXPERT), D ** -0.5),
        "w_up": nrm(ks[17], (L, N_EXPERTS, D, D_EXPERT), D ** -0.5),
        "w_down": nrm(ks[18], (L, N_EXPERTS, D_EXPERT, D), D_EXPERT ** -0.5),
        "final_g": 1.0 + nrm(ks[19], (D,), 0.05),
    }


def reference(x, c, w_ada, b_ada, norm_mix_g, w_in, b_forget, sinks, out_norm_swa_g, out_norm_fox_g, w_out,
              norm_moe_g, w_group, b_group, w_expert, b_expert, w_gate, w_up, w_down, final_g):
    B, S, D = x.shape
    col_splits = list(np.cumsum([SWA_WIDTH, KV_WIDTH, KV_WIDTH, FOX_WIDTH, FOX_WIDTH, FOX_WIDTH]))
    for l in range(DEPTH):
        mod = jax.nn.silu(c) @ w_ada[l] + b_ada[l]
        sh_a, sc_a, g_a, sh_m, sc_m, g_m = [m[:, None, :] for m in jnp.split(mod, 6, axis=-1)]

        h = rmsnorm(x, norm_mix_g[l]) * (1.0 + sc_a) + sh_a
        proj = h @ w_in[l]
        q_a, k_a, v_a, q_b, k_b, v_b, f_b = jnp.split(proj, col_splits, axis=-1)
        o_a = sliding_window_gqa(q_a.reshape(B, S, N_HEADS_SWA, HEAD_DIM),
                                 k_a.reshape(B, S, N_KV_SWA, HEAD_DIM),
                                 v_a.reshape(B, S, N_KV_SWA, HEAD_DIM), sinks[l])
        log_f = jax.nn.log_sigmoid(f_b.astype(jnp.float32) + b_forget[l].astype(jnp.float32))
        o_b = forgetting_attention(q_b.reshape(B, S, N_HEADS_FOX, HEAD_DIM),
                                   k_b.reshape(B, S, N_HEADS_FOX, HEAD_DIM),
                                   v_b.reshape(B, S, N_HEADS_FOX, HEAD_DIM), log_f)
        mixed = jnp.concatenate([rmsnorm(o_a, out_norm_swa_g[l]), rmsnorm(o_b, out_norm_fox_g[l])], axis=-1)
        x = x + g_a * (mixed @ w_out[l])

        h2 = rmsnorm(x, norm_moe_g[l]) * (1.0 + sc_m) + sh_m
        x = x + g_m * hierarchical_moe(h2, w_group[l], b_group[l], w_expert[l], b_expert[l],
                                       w_gate[l], w_up[l], w_down[l])
    return rmsnorm(x, final_g)
```

```cpp
#include <hip/hip_runtime.h>
#include <hip/hip_bf16.h>
#include <cstdio>
#include <cstdint>
#include <cmath>
namespace pg8 {
#define PG8_LAS __attribute__((address_space(3)))
typedef unsigned short bf16_t;
typedef short bf16x8 __attribute__((ext_vector_type(8)));
typedef float f32x4 __attribute__((ext_vector_type(4)));
typedef unsigned u32x4 __attribute__((ext_vector_type(4)));
constexpr int BM = 256, BK = 64, HALF = 128, HTB = HALF * BK * 2  , STAGE_BYTES = 8 * HTB, NXCD = 8, WGM = 8;
constexpr int LIST_CAP = 16384;

__host__ __device__ __forceinline__ int lds_byte(int r, int c) { const int st = (r >> 4) * 2 + (c >> 5), rr = r & 15, cc = c & 31, ob = rr * 64 + cc * 2; return st * 1024 + (ob ^ (((ob >> 9) & 1) << 5)); }
__host__ __device__ __forceinline__ void stage_rc(int b, int& R, int& C) { const int st = b / 1024, sb = b % 1024, swz = sb ^ (((sb >> 9) & 1) << 5); R = (st >> 1) * 16 + swz / 64; C = (st & 1) * 32 + (swz % 64) / 2; }
__host__ __device__ __forceinline__ int perm32(int rho) { const int n = rho >> 4, i = rho & 15; return 8 * (i >> 2) + 4 * n + (i & 3); }

struct Unit { int pm, pn, e, pl, nv; };
struct Gemm { const bf16_t* A; const bf16_t* Bt; int lda, K; };

struct StaticOrder {
    int nM, nN, nwg, G, c;
    __host__ __device__ void init(int M, int N, int G_, int c_) { nM = M / BM; nN = N / BM; nwg = nM * nN; G = G_; c = c_; }
    __host__ __device__ bool next(int i, Unit& u) const {
        const long L = (long)i * G + c; if (L >= nwg) return false;
        int wgid = (int)L; { const int q = nwg / NXCD, r = nwg % NXCD, xcd = wgid % NXCD, off = wgid / NXCD; wgid = (xcd < r ? xcd * (q + 1) : r * (q + 1) + (xcd - r) * q) + off; }
        const int nig = WGM * nN, gid = wgid / nig, fm = gid * WGM, gsz = (nM - fm) < WGM ? (nM - fm) : WGM;
        u.pm = fm + ((wgid % nig) % gsz); u.pn = (wgid % nig) / gsz; u.e = 0; u.pl = 0; u.nv = BM; return true;
    }
    __device__ __forceinline__ int arow(const Unit& u, int r) const { return u.pm * BM + r; }
    __device__ __forceinline__ void a_ready(const Unit&) const {}
    __device__ __forceinline__ void done(const Unit&) const {}
};
struct GroupedOrder {
    const PG8_LAS int* pfx; const PG8_LAS int* cnt; const int* list; int ntile, G, c;
    __device__ __forceinline__ bool next(int i, Unit& u) const {
        const int total = __builtin_amdgcn_readfirstlane(pfx[32]) * ntile; const long L = (long)i * G + c; if (L >= total) return false;
        const int pg = (int)L / ntile, pnl = (int)L % ntile; int e = 0;
#pragma unroll 8
        for (int j = 1; j < 32; ++j) e += (pg >= pfx[j]) ? 1 : 0;
        e = __builtin_amdgcn_readfirstlane(e);
        const int pl = pg - __builtin_amdgcn_readfirstlane(pfx[e]); const int rem = __builtin_amdgcn_readfirstlane(cnt[e]) - BM * pl;
        u.pm = pg; u.pn = e * ntile + pnl; u.e = e; u.pl = pl; u.nv = rem < BM ? rem : BM; return true;
    }
    __device__ __forceinline__ int arow(const Unit& u, int r) const { return list ? list[(size_t)u.e * LIST_CAP + u.pl * BM + (r < u.nv ? r : 0)] : u.pm * BM + r; }
    __device__ __forceinline__ void a_ready(const Unit&) const {}
    __device__ __forceinline__ void done(const Unit&) const {}
};

__device__ __forceinline__ unsigned cvt_pk_bf16(float lo, float hi) { unsigned r; asm volatile("v_cvt_pk_bf16_f32 %0, %1, %2" : "=v"(r) : "v"(lo), "v"(hi)); return r; }
__device__ __forceinline__ float log_sigmoid(float x) { return fminf(x, 0.f) - log1pf(expf(-fabsf(x))); }
__device__ __forceinline__ float silu_f(float g) { return g * __builtin_amdgcn_rcpf(1.0f + __builtin_amdgcn_exp2f(-1.4426950408889634f * g)); }

struct EpiProj {
    static constexpr bool PERM = true, AFTER_DRAIN = false;
    bf16_t* P; float* logf; const float* bfg; float qscale;
    __device__ __forceinline__ void operator()(const f32x4 (&acc)[2][2][4][2], const Unit& u, int wr, int wc, int fr, int fq) const {
        const int row0 = u.pm * BM + wr * 64 + fr;
        if (u.pn < 18) {
            const float sc = (u.pn < 4 || (u.pn >= 6 && u.pn < 10)) ? qscale : 1.f;
            const int col0 = u.pn * BM + wc * 32 + 8 * fq;
#pragma unroll
            for (int ai = 0; ai < 2; ++ai)
#pragma unroll
                for (int m = 0; m < 4; ++m) { bf16_t* rowp = P + (size_t)(row0 + ai * HALF + m * 16) * 4608 + col0;
#pragma unroll
                    for (int bj = 0; bj < 2; ++bj) { const f32x4 v0 = acc[ai][bj][m][0] * sc, v1 = acc[ai][bj][m][1] * sc;
                        u32x4 w; w.x = cvt_pk_bf16(v0[0], v0[1]); w.y = cvt_pk_bf16(v0[2], v0[3]); w.z = cvt_pk_bf16(v1[0], v1[1]); w.w = cvt_pk_bf16(v1[2], v1[3]);
                        *(u32x4*)(rowp + bj * HALF) = w; } }
        } else if (wc == 0 && fq < 2) {
#pragma unroll
            for (int n = 0; n < 2; ++n) { const int c0 = 8 * fq + 4 * n; const f32x4 bv = *(const f32x4*)(bfg + c0);
#pragma unroll
                for (int ai = 0; ai < 2; ++ai)
#pragma unroll
                    for (int m = 0; m < 4; ++m) { const f32x4 v = acc[ai][0][m][n] + bv; f32x4 o; o[0] = log_sigmoid(v[0]); o[1] = log_sigmoid(v[1]); o[2] = log_sigmoid(v[2]); o[3] = log_sigmoid(v[3]);
                        *(f32x4*)(logf + (size_t)(row0 + ai * HALF + m * 16) * 16 + c0) = o; } }
        }
    }
};
struct EpiResGate {
    static constexpr bool PERM = false, AFTER_DRAIN = false;
    const float* x; float* out; const float* mod;
    __device__ __forceinline__ void operator()(const f32x4 (&acc)[2][2][4][2], const Unit& u, int wr, int wc, int fr, int fq) const {
        const float* g = mod + (u.pm >= 32 ? 12288 : 0) + 2 * 2048; const int col0 = u.pn * BM + wc * 32 + 4 * fq;
        f32x4 gv[2][2];
#pragma unroll
        for (int bj = 0; bj < 2; ++bj)
#pragma unroll
            for (int n = 0; n < 2; ++n) gv[bj][n] = *(const f32x4*)(g + col0 + bj * HALF + n * 16);
#pragma unroll
        for (int ai = 0; ai < 2; ++ai)
#pragma unroll
            for (int m = 0; m < 4; ++m) { const size_t off = (size_t)(u.pm * BM + ai * HALF + wr * 64 + m * 16 + fr) * 2048 + col0;
#pragma unroll
                for (int bj = 0; bj < 2; ++bj)
#pragma unroll
                    for (int n = 0; n < 2; ++n) { const f32x4 xv = *(const f32x4*)(x + off + bj * HALF + n * 16); *(f32x4*)(out + off + bj * HALF + n * 16) = xv + gv[bj][n] * acc[ai][bj][m][n]; }
                asm volatile("" ::: "memory"); }
    }
};
struct EpiRouter {
    static constexpr bool PERM = false, AFTER_DRAIN = false;
    float* L;
    __device__ __forceinline__ void operator()(const f32x4 (&acc)[2][2][4][2], const Unit& u, int wr, int wc, int fr, int fq) const {
        if (wc < 2) {
#pragma unroll
            for (int ai = 0; ai < 2; ++ai)
#pragma unroll
                for (int m = 0; m < 4; ++m) { float* rp = L + (size_t)(u.pm * BM + ai * HALF + wr * 64 + m * 16 + fr) * 64 + wc * 32 + 4 * fq;
#pragma unroll
                    for (int n = 0; n < 2; ++n) *(f32x4*)(rp + n * 16) = acc[ai][0][m][n]; }
        }
    }
};
struct EpiSwiGLU {
    static constexpr bool PERM = true, AFTER_DRAIN = false;
    bf16_t* H;
    __device__ __forceinline__ void operator()(const f32x4 (&acc)[2][2][4][2], const Unit& u, int wr, int wc, int fr, int fq) const {
        const int col0 = (u.pn & 3) * 128 + wc * 32 + 8 * fq;
#pragma unroll
        for (int ai = 0; ai < 2; ++ai)
#pragma unroll
            for (int m = 0; m < 4; ++m) { bf16_t* rowp = H + (size_t)(u.pm * BM + ai * HALF + wr * 64 + m * 16 + fr) * 512 + col0;
                const f32x4 g0 = acc[ai][0][m][0], g1 = acc[ai][0][m][1], u0 = acc[ai][1][m][0], u1 = acc[ai][1][m][1];
                u32x4 w; w.x = cvt_pk_bf16(silu_f(g0[0]) * u0[0], silu_f(g0[1]) * u0[1]); w.y = cvt_pk_bf16(silu_f(g0[2]) * u0[2], silu_f(g0[3]) * u0[3]);
                w.z = cvt_pk_bf16(silu_f(g1[0]) * u1[0], silu_f(g1[1]) * u1[1]); w.w = cvt_pk_bf16(silu_f(g1[2]) * u1[2], silu_f(g1[3]) * u1[3]);
                *(u32x4*)rowp = w; }
    }
};
struct EpiDown {
    static constexpr bool PERM = true, AFTER_DRAIN = false;
    bf16_t* Y;
    __device__ __forceinline__ void operator()(const f32x4 (&acc)[2][2][4][2], const Unit& u, int wr, int wc, int fr, int fq) const {
        const int col0 = (u.pn & 7) * BM + wc * 32 + 8 * fq;
#pragma unroll
        for (int ai = 0; ai < 2; ++ai)
#pragma unroll
            for (int m = 0; m < 4; ++m) { bf16_t* rowp = Y + (size_t)(u.pm * BM + ai * HALF + wr * 64 + m * 16 + fr) * 2048 + col0;
#pragma unroll
                for (int bj = 0; bj < 2; ++bj) { const f32x4 v0 = acc[ai][bj][m][0], v1 = acc[ai][bj][m][1];
                    u32x4 w; w.x = cvt_pk_bf16(v0[0], v0[1]); w.y = cvt_pk_bf16(v0[2], v0[3]); w.z = cvt_pk_bf16(v1[0], v1[1]); w.w = cvt_pk_bf16(v1[2], v1[3]);
                    *(u32x4*)(rowp + bj * HALF) = w; } }
    }
};

template <class Epi, class Sched, bool ALIGN_EPI>
__device__ __forceinline__ void gemm_phase(PG8_LAS unsigned char* lds, const Gemm g, const Sched& S, const Epi& E) {
    const int tid = threadIdx.x, wid = __builtin_amdgcn_readfirstlane(tid >> 6), lane = tid & 63, wr = wid >> 2, wc = wid & 3, fr = lane & 15, fq = lane >> 4;
    const int K = g.K, nt = K / BK, lda = g.lda;
    int RA[2], CA[2]; unsigned voffB[2];
#pragma unroll
    for (int i = 0; i < 2; ++i) { int R, C; stage_rc(tid * 16 + i * 8192, R, C); const int Rb = Epi::PERM ? ((R & ~31) + perm32(R & 31)) : R;
        RA[i] = R; CA[i] = C; voffB[i] = (unsigned)(Rb * K + C) * 2u; }
    const size_t kstep = (size_t)(BK * 2);
    const size_t hstep = (size_t)HALF * K * 2;
    const size_t tstep = 2 * hstep;
    const unsigned ldsw = (unsigned)wid * 1024u;
    const int aoff = lds_byte(wr * 64 + fr, fq * 8), boff = lds_byte(wc * 32 + fr, fq * 8);
    const char* const Ab = (const char*)g.A;
#define PG8_SA(b, h) (((b) * 2 + (h)) * HTB)
#define PG8_SB(b, h) ((4 + (b) * 2 + (h)) * HTB)
#define PG8_STAGE(bufoff, gbase, voff) do { _Pragma("unroll") for (int _i = 0; _i < 2; ++_i) \
        __builtin_amdgcn_global_load_lds((const unsigned*)((const char*)(gbase) + (voff)[_i]), (PG8_LAS unsigned*)(lds + (bufoff) + ldsw + _i * 8192), 16, 0, 0); } while (0)
#define PG8_LDA(dst, b, h) do { _Pragma("unroll") for (int m = 0; m < 4; ++m) _Pragma("unroll") for (int k = 0; k < 2; ++k) dst[m][k] = *(const PG8_LAS bf16x8*)(lds + PG8_SA(b, h) + aoff + m * 2048 + k * 1024); } while (0)
#define PG8_LDB(dst, b, h) do { _Pragma("unroll") for (int n = 0; n < 2; ++n) _Pragma("unroll") for (int k = 0; k < 2; ++k) dst[n][k] = *(const PG8_LAS bf16x8*)(lds + PG8_SB(b, h) + boff + n * 2048 + k * 1024); } while (0)
#define PG8_MMA(ai, bj, At, Bt) do { __builtin_amdgcn_s_setprio(1); _Pragma("unroll") for (int m = 0; m < 4; ++m) _Pragma("unroll") for (int n = 0; n < 2; ++n) _Pragma("unroll") for (int k = 0; k < 2; ++k) \
        acc[ai][bj][m][n] = __builtin_amdgcn_mfma_f32_16x16x32_bf16(Bt[n][k], At[m][k], acc[ai][bj][m][n], 0, 0, 0); __builtin_amdgcn_s_setprio(0); } while (0)
#define PG8_WAIT_V(n) asm volatile("s_waitcnt vmcnt(" #n ")" ::: "memory")
#define PG8_WAIT_L(n) asm volatile("s_waitcnt lgkmcnt(" #n ")" ::: "memory")
#define PG8_BAR __builtin_amdgcn_s_barrier()
#define PG8_SCHED __builtin_amdgcn_sched_barrier(0)
#define PG8_AOFF(dst, u) do { _Pragma("unroll") for (int _h = 0; _h < 2; ++_h) _Pragma("unroll") for (int _i = 0; _i < 2; ++_i) \
        dst[_h][_i] = ((unsigned)S.arow(u, _h * HALF + RA[_i]) * (unsigned)lda + (unsigned)CA[_i]) * 2u; } while (0)
    Unit cur, nxt; int ui = 0;
    if (!S.next(0, cur)) return;
    f32x4 acc[2][2][4][2];
#pragma unroll
    for (int a = 0; a < 2; ++a)
#pragma unroll
        for (int b = 0; b < 2; ++b)
#pragma unroll
            for (int m = 0; m < 4; ++m)
#pragma unroll
                for (int n = 0; n < 2; ++n) acc[a][b][m][n] = (f32x4){0.f, 0.f, 0.f, 0.f};
    bf16x8 At[4][2], B0[2][2], B1[2][2];
    unsigned ca[2][2], na[2][2];
    PG8_AOFF(ca, cur);
    const char* cB = (const char*)g.Bt + (size_t)cur.pn * tstep;
    S.a_ready(cur);
    PG8_STAGE(PG8_SB(0, 0), cB, voffB); PG8_STAGE(PG8_SB(0, 1), cB + hstep, voffB); PG8_STAGE(PG8_SA(0, 0), Ab, ca[0]); PG8_STAGE(PG8_SA(0, 1), Ab, ca[1]);
    if (wr == 1) PG8_BAR;
    PG8_WAIT_V(2); PG8_BAR;
    PG8_STAGE(PG8_SB(1, 0), cB + kstep, voffB); PG8_STAGE(PG8_SA(1, 0), Ab + kstep, ca[0]); PG8_STAGE(PG8_SB(1, 1), cB + hstep + kstep, voffB);
    PG8_WAIT_V(6); PG8_BAR;
    for (;;) {
        const bool has_next = S.next(ui + 1, nxt);
        if (has_next) { PG8_AOFF(na, nxt); } else { na[0][0] = ca[0][0]; na[0][1] = ca[0][1]; na[1][0] = ca[1][0]; na[1][1] = ca[1][1]; }
        const char* nB = has_next ? (const char*)g.Bt + (size_t)nxt.pn * tstep : cB;
        for (int t = 0; t < nt; t += 2) {
            const bool last = (t == nt - 2);
            const char* a1 = Ab + (size_t)(t + 1) * kstep;
            const char* a2 = last ? Ab : Ab + (size_t)(t + 2) * kstep; const char* b2 = last ? nB : cB + (size_t)(t + 2) * kstep;
            const char* a3 = a2 + kstep; const char* b3 = b2 + kstep;
            unsigned o0[2], o1[2]; o0[0] = last ? na[0][0] : ca[0][0]; o0[1] = last ? na[0][1] : ca[0][1]; o1[0] = last ? na[1][0] : ca[1][0]; o1[1] = last ? na[1][1] : ca[1][1];
            if (last && has_next) S.a_ready(nxt);
            PG8_LDB(B0, 0, 0); PG8_LDB(B1, 0, 1); PG8_SCHED; PG8_LDA(At, 0, 0); PG8_STAGE(PG8_SA(1, 1), a1, ca[1]);
            PG8_WAIT_V(8); PG8_WAIT_L(0); PG8_BAR; PG8_MMA(0, 0, At, B0); PG8_MMA(0, 1, At, B1); PG8_BAR; PG8_SCHED;
            PG8_LDA(At, 0, 1); PG8_STAGE(PG8_SB(0, 0), b2, voffB); PG8_STAGE(PG8_SB(0, 1), b2 + hstep, voffB); PG8_STAGE(PG8_SA(0, 0), a2, o0);
            PG8_WAIT_V(8); PG8_WAIT_L(0); PG8_BAR; PG8_MMA(1, 0, At, B0); PG8_MMA(1, 1, At, B1); PG8_BAR; PG8_SCHED;
            PG8_LDB(B0, 1, 0); PG8_LDB(B1, 1, 1); PG8_SCHED; PG8_LDA(At, 1, 0); PG8_STAGE(PG8_SA(0, 1), a2, o1);
            PG8_WAIT_V(8); PG8_WAIT_L(0); PG8_BAR; PG8_MMA(0, 0, At, B0); PG8_MMA(0, 1, At, B1); PG8_BAR; PG8_SCHED;
            PG8_LDA(At, 1, 1); PG8_STAGE(PG8_SB(1, 0), b3, voffB); PG8_STAGE(PG8_SB(1, 1), b3 + hstep, voffB); PG8_STAGE(PG8_SA(1, 0), a3, o0);
            PG8_WAIT_V(8); PG8_WAIT_L(0); PG8_BAR; PG8_MMA(1, 0, At, B0); PG8_MMA(1, 1, At, B1); PG8_BAR; PG8_SCHED;
        }
        if constexpr (ALIGN_EPI) { if (wr == 0) PG8_BAR; }
        E(acc, cur, wr, wc, fr, fq); S.done(cur);
        if (!has_next) break;
#pragma unroll
        for (int a = 0; a < 2; ++a)
#pragma unroll
            for (int b = 0; b < 2; ++b)
#pragma unroll
                for (int m = 0; m < 4; ++m)
#pragma unroll
                    for (int n = 0; n < 2; ++n) acc[a][b][m][n] = (f32x4){0.f, 0.f, 0.f, 0.f};
        cur = nxt; cB = nB; ++ui; ca[0][0] = na[0][0]; ca[0][1] = na[0][1]; ca[1][0] = na[1][0]; ca[1][1] = na[1][1];
        if constexpr (ALIGN_EPI) { if (wr == 1) PG8_BAR; }
    }
    PG8_WAIT_V(0);
    if constexpr (!ALIGN_EPI) { if (wr == 0) PG8_BAR; }
    PG8_BAR;
#undef PG8_SA
#undef PG8_SB
#undef PG8_STAGE
#undef PG8_LDA
#undef PG8_LDB
#undef PG8_MMA
#undef PG8_WAIT_V
#undef PG8_WAIT_L
#undef PG8_BAR
#undef PG8_SCHED
#undef PG8_AOFF
}
}
#include <hip/hip_bf16.h>
#include <cmath>
namespace attn_body {
using bf16=__hip_bfloat16;
using bf16x8=__attribute__((ext_vector_type(8)))short;
using s16x4=__attribute__((ext_vector_type(4)))short;
using f32x16=__attribute__((ext_vector_type(16)))float;
using u32x4=__attribute__((ext_vector_type(4)))unsigned;
constexpr int BATCH=2,NHEAD=16,SEQ=8192,D=64,PP=4608,OP=2048;
constexpr int NW=8,QBLK=32,QB=QBLK*NW,KVBLK=64,NQB=SEQ/QB;
constexpr int ATTN_UNIT_ROWS=QB;
__device__ __forceinline__ int crow(int r,int hi){return (r&3)+8*(r>>2)+4*hi;}
#define SBAR() __builtin_amdgcn_sched_barrier(0)
__device__ __forceinline__ void cmask(f32x16&p0,f32x16&p1,int jb,int qrel,int hi){
  const float NEG=-INFINITY; int kb=64*jb+4*hi;
  #pragma unroll
  for(int r=0;r<16;++r){int kv=kb+(r&3)+8*(r>>2); if(kv>qrel)p0[r]=NEG; if(kv+32>qrel)p1[r]=NEG;}
}

typedef float f32x4v __attribute__((ext_vector_type(4)));
__device__ __forceinline__ void swamask(f32x16&p0,f32x16&p1,int kb0,int qrel,int hi){
  const float NEG=-INFINITY; const int d0=qrel-kb0-4*hi;
  #pragma unroll
  for(int r=0;r<16;++r){const int d=d0-((r&3)+8*(r>>2)); if((unsigned)d>=128u)p0[r]=NEG; if((unsigned)(d-32)>=128u)p1[r]=NEG;}
}
constexpr int NSLOT=3, SLOTB=8192;
constexpr int LDS_K=0, LDS_V=NSLOT*SLOTB, LDS_WS=2*NSLOT*SLOTB, LDS_OST=LDS_WS+NW*64*4, LDS_BIAS=LDS_OST+NW*4096, LDS_BYTES=LDS_BIAS+SEQ*4;
constexpr float C2=0.125f*1.4426950408889634f;
__device__ __forceinline__ void glds16(const void*gsrc,unsigned lds_dst){unsigned keep;
  asm volatile("s_mov_b32 %0, m0\n\ts_mov_b32 m0, %2\n\ts_nop 0\n\tglobal_load_lds_dwordx4 %1, off\n\ts_mov_b32 m0, %0":"=&s"(keep):"v"(gsrc),"s"(lds_dst):"memory");}
__device__ __forceinline__ float max3f(float a,float b,float c){float r;asm("v_max3_f32 %0, %1, %2, %3":"=v"(r):"v"(a),"v"(b),"v"(c));return r;}
__device__ __forceinline__ float max2f(float a,float b){float r;asm("v_max_f32_e32 %0, %1, %2":"=v"(r):"v"(a),"v"(b));return r;}
__device__ __forceinline__ float fadd_s(float a,float b){float r;asm("v_add_f32_e32 %0, %1, %2":"=v"(r):"v"(a),"v"(b));return r;}
__device__ __forceinline__ float fsub_s(float a,float b){float r;asm("v_sub_f32_e32 %0, %1, %2":"=v"(r):"v"(a),"v"(b));return r;}
typedef float f32x2_t __attribute__((ext_vector_type(2))); typedef __bf16 bf16x2_t __attribute__((ext_vector_type(2)));
__device__ __forceinline__ unsigned cvtpk_s(float lo,float hi){f32x2_t v={lo,hi};bf16x2_t b=__builtin_convertvector(v,bf16x2_t);return __builtin_bit_cast(unsigned,b);}
#define WAIT_BAR(N) asm volatile("s_waitcnt vmcnt(" #N ") lgkmcnt(0)\n\ts_barrier":::"memory")

__device__ __forceinline__ void qkt(f32x16&p0,f32x16&p1,const char*Kslot,const bf16x8*qr,int r32,int hi){
  const char*kb=Kslot+hi*1024+r32*16;
  #pragma unroll
  for(int d0=0;d0<4;++d0){
    const bf16x8 b0=*reinterpret_cast<const bf16x8*>(kb+d0*2048);
    const bf16x8 b1=*reinterpret_cast<const bf16x8*>(kb+d0*2048+512);
    p0=__builtin_amdgcn_mfma_f32_32x32x16_bf16(b0,qr[d0],p0,0,0,0);p1=__builtin_amdgcn_mfma_f32_32x32x16_bf16(b1,qr[d0],p1,0,0,0);}
}
typedef __attribute__((address_space(3))) const char* lds_cptr;
typedef short v4i16_t __attribute__((ext_vector_type(4)));
__device__ __forceinline__ void kload8(bf16x8*kf,lds_cptr kp){
  kf[0]=*(const __attribute__((address_space(3))) bf16x8*)(kp);      kf[1]=*(const __attribute__((address_space(3))) bf16x8*)(kp+512);
  kf[2]=*(const __attribute__((address_space(3))) bf16x8*)(kp+2048); kf[3]=*(const __attribute__((address_space(3))) bf16x8*)(kp+2560);
  kf[4]=*(const __attribute__((address_space(3))) bf16x8*)(kp+4096); kf[5]=*(const __attribute__((address_space(3))) bf16x8*)(kp+4608);
  kf[6]=*(const __attribute__((address_space(3))) bf16x8*)(kp+6144); kf[7]=*(const __attribute__((address_space(3))) bf16x8*)(kp+6656);
}
__device__ __forceinline__ void kload2(bf16x8*kf,lds_cptr kp,int j){ kf[2*j]=*(const __attribute__((address_space(3))) bf16x8*)(kp+j*2048); kf[2*j+1]=*(const __attribute__((address_space(3))) bf16x8*)(kp+j*2048+512); }
__device__ __forceinline__ s16x4 vtr(lds_cptr p){ return __builtin_bit_cast(s16x4,__builtin_amdgcn_ds_read_tr16_b64_v4i16((__attribute__((address_space(3))) v4i16_t*)p)); }
__device__ __forceinline__ float rowmax(const f32x16&p0,const f32x16&p1){
  float a=max3f(p0[0],p0[1],p1[0]),b=max3f(p0[2],p0[3],p1[1]);a=max3f(a,p1[2],p1[3]);
  #pragma unroll
  for(int r=4;r<16;r+=4){a=max3f(a,p0[r],p0[r+1]);b=max3f(b,p0[r+2],p0[r+3]);a=max3f(a,p1[r],p1[r+1]);b=max3f(b,p1[r+2],p1[r+3]);}
  const float m=max2f(a,b);
  auto rr=__builtin_amdgcn_permlane32_swap(__float_as_uint(m),__float_as_uint(m),false,false);
  return max2f(__uint_as_float(rr[0]),__uint_as_float(rr[1]));
}
__device__ __forceinline__ void pv(f32x16*o,int vb,bf16x8 pa0,bf16x8 pa1,bf16x8 pa2,bf16x8 pa3){
  #pragma unroll
  for(int d0=0;d0<2;++d0){s16x4 lo[4],hi[4];
    #pragma unroll
    for(int ks=0;ks<4;++ks){
      asm volatile("ds_read_b64_tr_b16 %0,%1 offset:%c2":"=&v"(lo[ks]):"v"(vb),"i"(d0*4096+ks*1024):"memory");
      asm volatile("ds_read_b64_tr_b16 %0,%1 offset:%c2":"=&v"(hi[ks]):"v"(vb),"i"(d0*4096+ks*1024+512):"memory");}
    asm volatile("s_waitcnt lgkmcnt(0)":::"memory");SBAR();
    #define PK(k) (bf16x8){lo[k][0],lo[k][1],lo[k][2],lo[k][3],hi[k][0],hi[k][1],hi[k][2],hi[k][3]}
    o[d0]=__builtin_amdgcn_mfma_f32_32x32x16_bf16(pa0,PK(0),o[d0],0,0,0);
    o[d0]=__builtin_amdgcn_mfma_f32_32x32x16_bf16(pa1,PK(1),o[d0],0,0,0);
    o[d0]=__builtin_amdgcn_mfma_f32_32x32x16_bf16(pa2,PK(2),o[d0],0,0,0);
    o[d0]=__builtin_amdgcn_mfma_f32_32x32x16_bf16(pa3,PK(3),o[d0],0,0,0);
    #undef PK
  }
}

#ifndef ATTN_STORE16
#define ATTN_STORE16(p,v) (*(u32x4*)(p)=(v))
#endif
template<int MODE,int THRL> __device__ __forceinline__ void attn_unit(int qb,const bf16*Qh,const bf16*__restrict__ Kh,const bf16*__restrict__ Vh,bf16*Oh,const float*__restrict__ biasg,float slope2,float sink2,char*shm){
  const int tid=threadIdx.x,lane=tid&63,r32=lane&31,hi=lane>>5; const int wid=__builtin_amdgcn_readfirstlane(tid>>6);
  const int q0=qb*QB;
  const int T0=(MODE==1)?(qb?4*qb-2:0):0;
  const int NT=(MODE==1)?(qb?6:4):(q0+QB)/KVBLK;
  const bf16*Qw=Qh+(long)(q0+wid*QBLK)*PP;
  const unsigned lds0=(unsigned)(uintptr_t)shm;
  float*wsf=(float*)(shm+LDS_WS)+wid*64;
  const bf16*ksrc=Kh+(long)(T0*KVBLK+lane)*PP+wid*8;
  const bf16*vsrc=Vh+(long)(T0*KVBLK+16*(wid&3)+(lane>>2))*PP+(wid>>2)*32+(lane&3)*8;
  const unsigned kdst=lds0+LDS_K+wid*1024, vdst=lds0+LDS_V+wid*1024;
  #define DMA_K(t,slot) glds16(ksrc+(long)(t)*KVBLK*PP,(unsigned)__builtin_amdgcn_readfirstlane(kdst+(slot)))
  #define DMA_V(t,slot) glds16(vsrc+(long)(t)*KVBLK*PP,(unsigned)__builtin_amdgcn_readfirstlane(vdst+(slot)))
  const int vb0=(int)(lds0+LDS_V)+((lane>>4)&1)*32+(lane&3)*8+(4*hi+((lane&15)>>2))*64;
  const char*Kbase=shm+LDS_K; bf16x8 kf[8];
  const lds_cptr shm3=(lds_cptr)shm; const lds_cptr kp0=shm3+LDS_K+hi*1024+r32*16; const lds_cptr vp0=shm3+LDS_V+((lane>>4)&1)*32+(lane&3)*8+(4*hi+((lane&15)>>2))*64;
  DMA_K(0,0);DMA_V(0,0);DMA_K(1,SLOTB);
  bf16x8 qr[4];
  #pragma unroll
  for(int d0=0;d0<4;++d0)qr[d0]=*reinterpret_cast<const bf16x8*>(&Qw[(long)r32*PP+d0*16+hi*8]);
  float mhat=0.f,l_reg=0.f;f32x16 o[2];o[0]=f32x16{};o[1]=f32x16{};
  const int qrel=wid*QBLK+r32;
  { __attribute__((address_space(3))) float*Tb=(__attribute__((address_space(3))) float*)(shm3+LDS_BIAS);
    if(MODE==0){ const float ref=biasg[q0]; for(int k=tid;k<NT*KVBLK;k+=NW*64)Tb[k]=biasg[k]-ref; }
    else{ const int koff=T0*KVBLK-q0; for(int k=tid;k<NT*KVBLK;k+=NW*64)Tb[k]=slope2*(float)(k+koff); } }
  const __attribute__((address_space(3))) f32x4v*Tl=(const __attribute__((address_space(3))) f32x4v*)(shm3+LDS_BIAS)+hi;
  const float sinkc=sink2+slope2*(float)qrel;
  #define CMASK(P0,P1,t) do{ if(MODE==1){ swamask(P0,P1,(T0+(t))*KVBLK-q0,qrel,hi); } else { int jb_=(t)-(NT-4); if(jb_>=0)cmask(P0,P1,jb_,qrel,hi); } }while(0)
  bool resc=false;
  #define START(P0,P1) do{ float rm=rowmax(P0,P1); if(MODE==1)rm=max2f(rm,sinkc); resc=false; \
    { const float dl=rm; mhat=fadd_s(mhat,dl); \
      _Pragma("unroll") for(int r=0;r<16;++r){P0[r]=fsub_s(P0[r],dl);P1[r]=fsub_s(P1[r],dl);} } \
    _Pragma("unroll") for(int r=0;r<16;++r)P0[r]=__builtin_amdgcn_exp2f(P0[r]); }while(0)
  #define RESC() do{ if(resc){ asm volatile("s_waitcnt lgkmcnt(0)":::"memory"); \
      _Pragma("unroll") for(int d_=0;d_<2;++d_) _Pragma("unroll") for(int r=0;r<16;++r)o[d_][r]*=wsf[crow(r,hi)]; } }while(0)
  #define BL0(X0,t,g_) do{ const f32x4v a_=Tl[(t)*16+2*(g_)]; X0[4*(g_)]=a_[0];X0[4*(g_)+1]=a_[1];X0[4*(g_)+2]=a_[2];X0[4*(g_)+3]=a_[3]; }while(0)
  #define BL1(X1,t,g_) do{ const f32x4v b_=Tl[(t)*16+8+2*(g_)]; X1[4*(g_)]=b_[0];X1[4*(g_)+1]=b_[1];X1[4*(g_)+2]=b_[2];X1[4*(g_)+3]=b_[3]; }while(0)
  #define BLALL(X0,X1,t) do{ BL0(X0,t,0);BL0(X0,t,1);BL0(X0,t,2);BL0(X0,t,3);BL1(X1,t,0);BL1(X1,t,1);BL1(X1,t,2);BL1(X1,t,3); }while(0)
  #define SUBM(X0,X1) do{ _Pragma("unroll") for(int r=0;r<16;++r){X0[r]-=mhat;X1[r]-=mhat;} }while(0)
  f32x16 pA0,pA1,pB0,pB1;
  int sl_prev=0,sl_cur=0,sl_next=SLOTB;
  #define ROT() do{sl_prev=sl_cur;sl_cur=sl_next;sl_next=(sl_next==(NSLOT-1)*SLOTB)?0:sl_next+SLOTB;}while(0)
  DMA_K(2,2*SLOTB);
  WAIT_BAR(3);
  BLALL(pA0,pA1,0);
  qkt(pA0,pA1,Kbase,qr,r32,hi);asm volatile("s_nop 15\n\ts_nop 7":"+v"(pA0),"+v"(pA1));CMASK(pA0,pA1,0);
  START(pA0,pA1);
  _Pragma("unroll") for(int r=0;r<16;++r)pA1[r]=__builtin_amdgcn_exp2f(pA1[r]);
  BLALL(pB0,pB1,1);
  WAIT_BAR(0);
  DMA_K(3,0);DMA_V(1,SLOTB);
  ROT();
  kload8(kf,kp0+sl_cur);
  WAIT_BAR(2);
  s16x4 vlo[8],vhi[8]; u32x4 pw0,pw1,pw2,pw3;
  #define PKW(P,B) cvtpk_s(P[B],P[B+1])
  #define PAF(k) __builtin_bit_cast(bf16x8,pw##k)
  #define VFR(i) (bf16x8){vlo[i][0],vlo[i][1],vlo[i][2],vlo[i][3],vhi[i][0],vhi[i][1],vhi[i][2],vhi[i][3]}
  #define PIN(x) asm volatile("":"+v"(x))
  #define MX3(a,b,c) __builtin_fmaxf(__builtin_fmaxf((a),(b)),(c))
  #define GAPA(MF,A0,A1,A2,A3,W0,W1,PW) do{ MF; sacc+=A0; sacc+=A1; sacc+=A2; sacc+=A3; PIN(sacc); W0; W1; PIN(PW); SBAR(); }while(0)
  #define EX(v) __builtin_amdgcn_exp2f(v)
  #define GAPB(MF,X,B) do{ MF; X[B]=EX(X[B]); X[B+1]=EX(X[B+1]); X[B+2]=EX(X[B+2]); X[B+3]=EX(X[B+3]); PIN(X); SBAR(); }while(0)
  #define VRD(i) do{ vlo[i]=vtr(vp_+(((i)>>2)*4096+((i)&3)*1024)); vhi[i]=vtr(vp_+(((i)>>2)*4096+((i)&3)*1024+512)); }while(0)
  #define KRD(G,j) do{ if(G){ kload2(kf,kp0+sl_next,j); SBAR(); } }while(0)
  #define BLD(G,LD) do{ if(G){ LD; SBAR(); } }while(0)
  #define STEP(C0,C1,P0,P1,t,GK,GV,GL) do{ SBAR(); SUBM(C0,C1); SBAR(); \
    const lds_cptr vp_=vp0+sl_prev; \
    VRD(0); SBAR(); float sacc=(P0[0]+P0[1]); \
    GAPA(C0=__builtin_amdgcn_mfma_f32_32x32x16_bf16(kf[0],qr[0],C0,0,0,0), P0[2],P0[3],P0[4],P0[5],     pw0[0]=PKW(P0,0), pw0[1]=PKW(P0,2), pw0); \
    VRD(4); SBAR(); GAPA(C1=__builtin_amdgcn_mfma_f32_32x32x16_bf16(kf[1],qr[0],C1,0,0,0), P0[6],P0[7],P0[8],P0[9],     pw0[2]=PKW(P0,4), pw0[3]=PKW(P0,6), pw0); \
    VRD(1); SBAR(); GAPA(C0=__builtin_amdgcn_mfma_f32_32x32x16_bf16(kf[2],qr[1],C0,0,0,0),   P0[10],P0[11],P0[12],P0[13], pw1[0]=PKW(P0,8), pw1[1]=PKW(P0,10), pw1); \
    VRD(5); SBAR(); GAPA(C1=__builtin_amdgcn_mfma_f32_32x32x16_bf16(kf[3],qr[1],C1,0,0,0),   P0[14],P0[15],P1[0],P1[1],   pw1[2]=PKW(P0,12),pw1[3]=PKW(P0,14), pw1); \
    VRD(2); SBAR(); GAPA(C0=__builtin_amdgcn_mfma_f32_32x32x16_bf16(kf[4],qr[2],C0,0,0,0),   P1[2],P1[3],P1[4],P1[5],     pw2[0]=PKW(P1,0), pw2[1]=PKW(P1,2), pw2); \
    VRD(6); SBAR(); GAPA(C1=__builtin_amdgcn_mfma_f32_32x32x16_bf16(kf[5],qr[2],C1,0,0,0),   P1[6],P1[7],P1[8],P1[9],     pw2[2]=PKW(P1,4), pw2[3]=PKW(P1,6), pw2); \
    VRD(3); SBAR(); GAPA(C0=__builtin_amdgcn_mfma_f32_32x32x16_bf16(kf[6],qr[3],C0,0,0,0),   P1[10],P1[11],P1[12],P1[13], pw3[0]=PKW(P1,8), pw3[1]=PKW(P1,10), pw3); \
    VRD(7); SBAR(); GAPA(C1=__builtin_amdgcn_mfma_f32_32x32x16_bf16(kf[7],qr[3],C1,0,0,0),   P1[14],P1[15],0.f,0.f,       pw3[2]=PKW(P1,12),pw3[3]=PKW(P1,14), pw3); \
    l_reg+=sacc; \
    if(GK){DMA_K((t)+3,sl_cur);} if(GV){DMA_V((t)+1,sl_next);} \
    CMASK(C0,C1,t); \
    { float a=MX3(C0[0],C0[1],C1[0]),b=MX3(C0[2],C0[3],C1[1]); a=MX3(a,C1[2],C1[3]); \
      _Pragma("unroll") for(int r=4;r<16;r+=4){a=MX3(a,C0[r],C0[r+1]);b=MX3(b,C0[r+2],C0[r+3]);a=MX3(a,C1[r],C1[r+1]);b=MX3(b,C1[r+2],C1[r+3]);} \
      float rm=__builtin_fmaxf(a,b); { auto rr=__builtin_amdgcn_permlane32_swap(__float_as_uint(rm),__float_as_uint(rm),false,false); rm=__builtin_fmaxf(__uint_as_float(rr[0]),__uint_as_float(rr[1])); } \
      resc=false; \
      if(__builtin_expect(__any(rm>(float)THRL),0)){ const float dl=__builtin_fmaxf(rm,0.f); mhat+=dl; \
        _Pragma("unroll") for(int r=0;r<16;++r){C0[r]-=dl;C1[r]-=dl;} \
        const float f=__builtin_amdgcn_exp2f(-dl); l_reg*=f; if(hi==0)wsf[r32]=f; resc=true; } } \
    SBAR(); \
    BLD(GL,BL0(P0,(t)+1,0);BL0(P0,(t)+1,1)); GAPB(o[0]=__builtin_amdgcn_mfma_f32_32x32x16_bf16(PAF(0),VFR(0),o[0],0,0,0), C0,0); \
    BLD(GL,BL0(P0,(t)+1,2);BL0(P0,(t)+1,3)); GAPB(o[1]=__builtin_amdgcn_mfma_f32_32x32x16_bf16(PAF(0),VFR(4),o[1],0,0,0), C0,4); \
    KRD(GL,0); GAPB(o[0]=__builtin_amdgcn_mfma_f32_32x32x16_bf16(PAF(1),VFR(1),o[0],0,0,0), C0,8); \
    KRD(GL,1); GAPB(o[1]=__builtin_amdgcn_mfma_f32_32x32x16_bf16(PAF(1),VFR(5),o[1],0,0,0), C0,12); \
    KRD(GL,2); GAPB(o[0]=__builtin_amdgcn_mfma_f32_32x32x16_bf16(PAF(2),VFR(2),o[0],0,0,0), C1,0); \
    KRD(GL,3); GAPB(o[1]=__builtin_amdgcn_mfma_f32_32x32x16_bf16(PAF(2),VFR(6),o[1],0,0,0), C1,4); \
    BLD(GL,BL1(P1,(t)+1,0);BL1(P1,(t)+1,1)); GAPB(o[0]=__builtin_amdgcn_mfma_f32_32x32x16_bf16(PAF(3),VFR(3),o[0],0,0,0), C1,8); \
    BLD(GL,BL1(P1,(t)+1,2);BL1(P1,(t)+1,3)); GAPB(o[1]=__builtin_amdgcn_mfma_f32_32x32x16_bf16(PAF(3),VFR(7),o[1],0,0,0), C1,12); \
    }while(0)
  int t=1;
  #undef CMASK
  #define CMASK(P0,P1,t) do{}while(0)
  for(;t+5<NT;t+=2){
    STEP(pB0,pB1,pA0,pA1,t,true,true,true);     WAIT_BAR(2); RESC(); ROT();
    STEP(pA0,pA1,pB0,pB1,t+1,true,true,true);   WAIT_BAR(2); RESC(); ROT();
  }
  #undef CMASK
  #define CMASK(P0,P1,t) do{ if(MODE==1){ swamask(P0,P1,(T0+(t))*KVBLK-q0,qrel,hi); } else { int jb_=(t)-(NT-4); if(jb_>=0)cmask(P0,P1,jb_,qrel,hi); } }while(0)
  #define ENDW(tt) do{ if((tt)+3<NT){WAIT_BAR(2);} else if((tt)+2<NT){WAIT_BAR(1);} else {WAIT_BAR(0);} }while(0)
  for(;t+1<NT;t+=2){
    STEP(pB0,pB1,pA0,pA1,t,(t+3<NT),(t+1<NT),(t+1<NT));       ENDW(t);   RESC(); ROT();
    STEP(pA0,pA1,pB0,pB1,t+1,(t+4<NT),(t+2<NT),(t+2<NT));     ENDW(t+1); RESC(); ROT();
  }
  STEP(pB0,pB1,pA0,pA1,NT-1,false,false,false); RESC();
  { float sacc=pB0[0]+pB0[1]; _Pragma("unroll") for(int r=2;r<16;++r)sacc+=pB0[r]; _Pragma("unroll") for(int r=0;r<16;++r)sacc+=pB1[r]; l_reg+=sacc;
    pw0=(u32x4){PKW(pB0,0),PKW(pB0,2),PKW(pB0,4),PKW(pB0,6)};pw1=(u32x4){PKW(pB0,8),PKW(pB0,10),PKW(pB0,12),PKW(pB0,14)};pw2=(u32x4){PKW(pB1,0),PKW(pB1,2),PKW(pB1,4),PKW(pB1,6)};pw3=(u32x4){PKW(pB1,8),PKW(pB1,10),PKW(pB1,12),PKW(pB1,14)};
    SBAR(); pv(o,vb0+sl_cur,PAF(0),PAF(1),PAF(2),PAF(3)); }
  #undef PKW
  #undef PAF
  #undef VFR
  #undef PIN
  #undef MX3
  #undef GAPA
  #undef GAPB
  #undef EX
  #undef VRD
  #undef KRD
  #undef BLD
  #undef STEP
  #undef ENDW
  {auto rr=__builtin_amdgcn_permlane32_swap(__float_as_uint(l_reg),__float_as_uint(l_reg),false,false);l_reg=__uint_as_float(rr[0])+__uint_as_float(rr[1]);}
  if(MODE==1)l_reg+=__builtin_amdgcn_exp2f(sinkc-mhat);
  if(hi==0)wsf[32+r32]=l_reg;asm volatile("s_waitcnt lgkmcnt(0)":::"memory");
  float rli[16];
  #pragma unroll
  for(int r=0;r<16;++r)rli[r]=__builtin_amdgcn_rcpf(wsf[32+crow(r,hi)]);
  bf16*Ow=Oh+(long)(q0+wid*QBLK)*OP;
  { bf16*stg=(bf16*)(shm+LDS_OST)+wid*2048;
    #pragma unroll
    for(int r=0;r<16;++r){const int orow=crow(r,hi);
      #pragma unroll
      for(int d0=0;d0<2;++d0)stg[orow*64+d0*32+r32]=__float2bfloat16(o[d0][r]*rli[r]);}
    asm volatile("s_waitcnt lgkmcnt(0)":::"memory");
    #pragma unroll
    for(int i=0;i<4;++i){const int row=i*8+(lane>>3),ch=lane&7; const u32x4 v=*(const u32x4*)(stg+row*64+ch*8); ATTN_STORE16(Ow+(long)row*OP+ch*8,v);} }
  asm volatile("s_waitcnt lgkmcnt(0)\n\ts_barrier":::"memory");
  #undef DMA_K
  #undef DMA_V
  #undef CMASK
  #undef BL0
  #undef BL1
  #undef BLALL
  #undef SUBM
  #undef START
  #undef RESC
  #undef ROT
}
constexpr int ATTN_LDS_BYTES=LDS_BYTES;
struct AttnArgs { const bf16* proj; bf16* obuf; const float* bias; const float* sinks; };
template<int THRL=8> __device__ __forceinline__ void attn_phase(char*lds,const AttnArgs&T,int vcu,int G){
  for(int j=vcu;j<1024;j+=G){
    const int v=j&255,i=j>>8,bh=v>>3,s=v&7,b=bh>>4,h=bh&15; const long rb=(long)b*SEQ; const int qb=4*s+i;
    const float slope2=exp2f(-0.5f*(float)(h+1))*1.4426950408889634f, sink2=T.sinks[h]*1.4426950408889634f;
    attn_unit<1,THRL>(qb,T.proj+rb*PP+h*D,T.proj+rb*PP+1024+(h>>2)*D,T.proj+rb*PP+1280+(h>>2)*D,T.obuf+rb*OP+h*D,nullptr,slope2,sink2,lds);
  }
  for(int j=vcu;j<1024;j+=G){
    const int v=j&255,i=j>>8,bh=v>>3,s=v&7,b=bh>>4,h=bh&15; const long rb=(long)b*SEQ; const int qb=(i==0)?s:(i==1)?15-s:(i==2)?16+s:31-s;
    attn_unit<0,THRL>(qb,T.proj+rb*PP+1536+h*D,T.proj+rb*PP+2560+h*D,T.proj+rb*PP+3584+h*D,T.obuf+rb*OP+1024+h*D,T.bias+(long)bh*SEQ,0.f,0.f,lds);
  }
}
#undef SBAR
#undef WAIT_BAR
}

constexpr int NWAVES = 8;
#ifndef MK_N_LAUNCHES
#define MK_N_LAUNCHES 1
#endif
constexpr int PER_PHASE = 13;
constexpr int N_LAUNCHES = MK_N_LAUNCHES;
constexpr int BATCH = 2, SEQ = 8192, DM = 2048, M = BATCH * SEQ;
constexpr int NPROJ = 4864, PROJ_P = 4608, NCOLS_IN = 4624;
constexpr int NEXP = 32, DEXP = 512, LIST_CAP = pg8::LIST_CAP;
constexpr float EPS = 1e-6f;
constexpr size_t MiB = 1u << 20;
constexpr size_t WS_CTL = 0, CTL_ZERO_BYTES = 1 * MiB;
constexpr size_t WS_MOD = 1 * MiB;
constexpr size_t WS_LOGF = 2 * MiB;
constexpr size_t WS_BIAS = 3 * MiB;
constexpr size_t WS_LOGITS = 4 * MiB;
constexpr size_t WS_SLOT = 8 * MiB;
constexpr size_t WS_EW = 8 * MiB + 512 * 1024;
constexpr size_t WS_LIST = 9 * MiB;
constexpr size_t WS_WR = 12 * MiB;
constexpr size_t WS_WIN = 13 * MiB;
constexpr size_t WS_WOUT = 32 * MiB;
constexpr size_t WS_WGU = 40 * MiB;
constexpr size_t WS_WDN = 168 * MiB;
constexpr size_t WS_XN = 232 * MiB;
constexpr size_t WS_PROJ = 296 * MiB;
constexpr size_t WS_OBUF = 440 * MiB;
constexpr size_t WS_HID = 504 * MiB;
constexpr size_t WS_YS = WS_PROJ;
constexpr size_t WS_END = 544 * MiB;
static_assert(WS_YS + (size_t)40960 * 2048 * 2 <= WS_HID && WS_HID + (size_t)40960 * 512 * 2 <= WS_END, "d_ws map");
constexpr int CW_TMO = 0, CW_CODE = 1, CW_BAR = 4096, CW_CNT = 8192;
constexpr int RING_OFF = 0, RING_BYTES = 131072;
constexpr int LDSCTL_OFF = RING_BYTES, MISC_OFF = LDSCTL_OFF + 320;
constexpr int LDS_BYTES = 147456;
static_assert(attn_body::ATTN_LDS_BYTES <= RING_BYTES && pg8::STAGE_BYTES <= RING_BYTES, "phase scratch fits the ring region");
#define GAS __attribute__((address_space(1)))
#define LAS __attribute__((address_space(3)))
typedef unsigned short bf16;
typedef unsigned v4u __attribute__((ext_vector_type(4)));
typedef float f32x4 __attribute__((ext_vector_type(4)));
typedef short bf16x8 __attribute__((ext_vector_type(8)));
typedef GAS unsigned gu32;
typedef GAS unsigned long long gu64;
#define RLX_AGENT __ATOMIC_RELAXED, __HIP_MEMORY_SCOPE_AGENT
#define LDS_WAIT() asm volatile("s_waitcnt lgkmcnt(0)" ::: "memory")
#define VM_WAIT() asm volatile("s_waitcnt vmcnt(0)" ::: "memory")
__device__ __forceinline__ unsigned long long rt() { return __builtin_amdgcn_s_memrealtime(); }
__device__ __forceinline__ unsigned f2bf(float f) { unsigned u = __builtin_bit_cast(unsigned, f); return (u + 0x7fffu + ((u >> 16) & 1u)) >> 16; }
__device__ __forceinline__ unsigned pk2(float lo, float hi) { return f2bf(lo) | (f2bf(hi) << 16); }

#define XB_TMO      128
#define XB_XCNT(j)  (256  + 64 * (j))
#define XB_XSUB(j)  (1280 + 64 * (j))
#define XB_XGEN(j)  (2304 + 64 * (j))
#define XB_TOP      3328
#define XB_TOPGEN   3392
#define XCD_BAR_WORDS 3456
#define XB_SPIN_CAP (1u << 18)

__device__ __forceinline__ unsigned xb_ld(unsigned* p)              { return __hip_atomic_load(p, __ATOMIC_RELAXED, __HIP_MEMORY_SCOPE_AGENT); }
__device__ __forceinline__ unsigned xb_add(unsigned* p, unsigned v) { return __hip_atomic_fetch_add(p, v, __ATOMIC_RELAXED, __HIP_MEMORY_SCOPE_AGENT); }
__device__ __forceinline__ unsigned xb_xcc_id() { return (unsigned)__builtin_amdgcn_s_getreg((3 << 11) | 20) & 0xFu; }
#define XB_SPIN(cond, bar) do { unsigned _sp = 0; while (cond) { __builtin_amdgcn_s_sleep(1); \
    if ((++_sp & 255u) == 0u) { if (xb_ld(&(bar)[XB_TMO])) break; if (_sp > XB_SPIN_CAP) { atomicAdd(&(bar)[XB_TMO], 1u); break; } } } } while (0)

struct XcdBarrier {
    unsigned* bar; unsigned x;
    volatile LAS unsigned* st;
};

__device__ __forceinline__ XcdBarrier xcd_barrier_post(unsigned* bar, volatile LAS unsigned* st) {
    XcdBarrier b; b.bar = bar; b.x = xb_xcc_id(); b.st = st;
    if (threadIdx.x == 0) (void)xb_add(&bar[XB_XCNT(b.x)], 1u);
    return b;
}
__device__ __forceinline__ void xcd_barrier_complete(unsigned* bar, unsigned x, unsigned& nloc, unsigned& nx) {
    const unsigned G = gridDim.x * gridDim.y * gridDim.z;
    unsigned sum, cnt, mine, sp = 0u;
    for (;;) {
        sum = 0u; cnt = 0u; mine = 0u;
#pragma unroll
        for (unsigned j = 0; j < 16; ++j) { const unsigned c = xb_ld(&bar[XB_XCNT(j)]); sum += c; cnt += (c > 0u) ? 1u : 0u; mine = (j == x) ? c : mine; }
        if (sum == G) break;
        __builtin_amdgcn_s_sleep(1);
        if ((++sp & 255u) == 0u) { if (xb_ld(&bar[XB_TMO])) break; if (sp > XB_SPIN_CAP) { atomicAdd(&bar[XB_TMO], 1u); break; } }
    }
    nloc = mine > 0u ? mine : 1u; nx = cnt > 0u ? cnt : 1u;
}

__device__ __forceinline__ void xcd_barrier(const XcdBarrier& b) {
    asm volatile("s_waitcnt vmcnt(0)" ::: "memory");
    __syncthreads();
    if (threadIdx.x == 0) {
        unsigned* bar = b.bar;
        __builtin_amdgcn_s_waitcnt(0);
        unsigned nloc = b.st[0], nx = b.st[1];
        if (nloc == 0u) { xcd_barrier_complete(bar, b.x, nloc, nx); b.st[0] = nloc; b.st[1] = nx; }
        const unsigned old = xb_add(&bar[XB_XSUB(b.x)], 1u);
        const unsigned gen = old / nloc;
        if (old + 1u == (gen + 1u) * nloc) {
            __builtin_amdgcn_fence(__ATOMIC_RELEASE, "agent");
            asm volatile("s_waitcnt vmcnt(0)" ::: "memory");
            const unsigned og = xb_add(&bar[XB_TOP], 1u);
            const unsigned tg = og / nx;
            if (og + 1u == (tg + 1u) * nx) xb_add(&bar[XB_TOPGEN], 1u);
            else XB_SPIN(xb_ld(&bar[XB_TOPGEN]) == tg, bar);
            __builtin_amdgcn_fence(__ATOMIC_ACQUIRE, "agent");
            xb_add(&bar[XB_XGEN(b.x)], 1u);
            asm volatile("s_waitcnt vmcnt(0)" ::: "memory");
        } else {
            XB_SPIN(xb_ld(&bar[XB_XGEN(b.x)]) == gen, bar);
            __builtin_amdgcn_fence(__ATOMIC_ACQUIRE, "agent");
            asm volatile("s_waitcnt vmcnt(0)" ::: "memory");
        }
    }
    __syncthreads();
}

__device__ __forceinline__ float wave_sum(float v) {
#pragma unroll
    for (int o = 1; o < 64; o <<= 1) v += __shfl_xor(v, o);
    return v;
}
__device__ __forceinline__ void p0_mod_item(LAS unsigned char* lds, const float* c, const float* w_ada, const float* b_ada, float* mod, int item, int tid) {
    LAS float* sc = (LAS float*)lds; LAS float* red = (LAS float*)(lds + 16384);
    for (int i = tid; i < 2 * DM; i += NWAVES * 64) { const float v = c[i]; sc[i] = v / (1.0f + expf(-v)); }
    __syncthreads();
    const int cg = tid & 15, rg = tid >> 4, n0 = item * 64;
    f32x4 a0 = {0.f, 0.f, 0.f, 0.f}, a1 = {0.f, 0.f, 0.f, 0.f};
    const float* wp = w_ada + (size_t)rg * (6 * DM) + n0 + 4 * cg;
#pragma unroll 8
    for (int k = rg; k < DM; k += 32) { const f32x4 w = *(const f32x4*)wp; wp += (size_t)32 * (6 * DM); a0 += sc[k] * w; a1 += sc[DM + k] * w; }
    *(LAS f32x4*)(red + (rg * 2 + 0) * 64 + 4 * cg) = a0; *(LAS f32x4*)(red + (rg * 2 + 1) * 64 + 4 * cg) = a1;
    __syncthreads();
    if (tid < 128) { const int b = tid >> 6, col = tid & 63; float s = 0.f;
#pragma unroll 8
        for (int r = 0; r < 32; ++r) s += red[(r * 2 + b) * 64 + col];
        mod[b * (6 * DM) + n0 + col] = s + b_ada[n0 + col]; }
    __syncthreads();
}
__device__ __forceinline__ void tr_item(const float* W, int Nsrc, int k0, int n0, bf16* dst, int Kd, LAS float* scr, int lane) {
    const int n = n0 + (lane & 31);
#pragma unroll 8
    for (int i = 0; i < 32; ++i) { const int kk = 2 * i + (lane >> 5); float v = 0.f; if (n < Nsrc) v = W[(size_t)(k0 + kk) * Nsrc + n]; scr[kk * 33 + (lane & 31)] = v; }
    LDS_WAIT(); asm volatile("" ::: "memory");
    const int c = lane & 7;
#pragma unroll
    for (int j = 0; j < 4; ++j) { const int nn = (lane >> 3) + 8 * j; const LAS float* s = scr + (8 * c) * 33 + nn;
        v4u o; o.x = pk2(s[0 * 33], s[1 * 33]); o.y = pk2(s[2 * 33], s[3 * 33]); o.z = pk2(s[4 * 33], s[5 * 33]); o.w = pk2(s[6 * 33], s[7 * 33]);
        *(GAS v4u*)(dst + (size_t)nn * Kd + k0 + 8 * c) = o; }
    LDS_WAIT(); asm volatile("" ::: "memory");
}
__device__ __forceinline__ void norm_mod_rows(const float* X, const float* g, const float* mod, int ish, int isc, bf16* OUT, int gw, int NGW, int lane) {
    int curb = -1; f32x4 ca[8], cb[8];
    for (int m = gw; m < M; m += NGW) {
        const int b = m >= SEQ ? 1 : 0;
        if (b != curb) { curb = b;
#pragma unroll
            for (int j = 0; j < 8; ++j) { const int col = 4 * lane + 256 * j; const f32x4 gv = *(const f32x4*)(g + col), sv = *(const f32x4*)(mod + b * (6 * DM) + isc * DM + col);
                ca[j] = gv * (sv + 1.0f); cb[j] = *(const f32x4*)(mod + b * (6 * DM) + ish * DM + col); } }
        const GAS f32x4* xr = (const GAS f32x4*)(X + (size_t)m * DM) + lane;
        f32x4 v[8]; float s = 0.f;
#pragma unroll
        for (int j = 0; j < 8; ++j) { v[j] = xr[64 * j]; s += (v[j].x * v[j].x + v[j].y * v[j].y) + (v[j].z * v[j].z + v[j].w * v[j].w); }
        const float rstd = 1.0f / sqrtf(wave_sum(s) * (1.0f / DM) + EPS);
        GAS unsigned long long* o8 = (GAS unsigned long long*)(OUT + (size_t)m * DM) + lane;
#pragma unroll
        for (int j = 0; j < 8; ++j) { const f32x4 h = v[j] * rstd * ca[j] + cb[j]; o8[64 * j] = (unsigned long long)pk2(h.x, h.y) | ((unsigned long long)pk2(h.z, h.w) << 32); }
    }
}
__device__ __forceinline__ float bf_lo(unsigned w) { return __builtin_bit_cast(float, w << 16); }
__device__ __forceinline__ float bf_hi(unsigned w) { return __builtin_bit_cast(float, w & 0xffff0000u); }
__device__ __forceinline__ void onorm_rows(bf16* O, const float* ga, const float* gb, int gw, int NGW, int lane) {
    f32x4 gg[4][2];
#pragma unroll
    for (int j = 0; j < 4; ++j) { const float* gp = (j < 2 ? ga + 512 * j : gb + 512 * (j - 2)) + 8 * lane; gg[j][0] = *(const f32x4*)gp; gg[j][1] = *(const f32x4*)(gp + 4); }
    for (int m = gw; m < M; m += NGW) {
        GAS v4u* row = (GAS v4u*)(O + (size_t)m * DM) + lane; v4u w[4]; float ss[4];
#pragma unroll
        for (int j = 0; j < 4; ++j) { w[j] = row[64 * j]; float s = 0.f;
#pragma unroll
            for (int q = 0; q < 4; ++q) { const float a = bf_lo(w[j][q]), b = bf_hi(w[j][q]); s += a * a + b * b; } ss[j] = s; }
        const float ra = 1.0f / sqrtf(wave_sum(ss[0] + ss[1]) * (1.0f / 1024.0f) + EPS), rb = 1.0f / sqrtf(wave_sum(ss[2] + ss[3]) * (1.0f / 1024.0f) + EPS);
#pragma unroll
        for (int j = 0; j < 4; ++j) { const float r = j < 2 ? ra : rb; v4u o;
#pragma unroll
            for (int q = 0; q < 4; ++q) { const float g0 = gg[j][q >> 1][(q & 1) * 2], g1 = gg[j][q >> 1][(q & 1) * 2 + 1]; o[q] = pk2(bf_lo(w[j][q]) * r * g0, bf_hi(w[j][q]) * r * g1); }
            row[64 * j] = o; }
    }
}
__device__ __forceinline__ void scan_seq(LAS unsigned char* lds, const float* logf, float* bias, int bh, int tid) {
    LAS float* wt = (LAS float*)lds; const int b = bh >> 4, h = bh & 15, lane = tid & 63, w = tid >> 6;
    const float* src = logf + ((size_t)b * SEQ + 16 * tid) * 16 + h; float v[16]; float tot = 0.f;
#pragma unroll
    for (int i = 0; i < 16; ++i) { tot += src[i * 16]; v[i] = tot; }
    float inc = tot;
#pragma unroll
    for (int o = 1; o < 64; o <<= 1) { const float t = __shfl_up(inc, o); if (lane >= o) inc += t; }
    if (lane == 63) wt[w] = inc;
    __syncthreads();
    float base = 0.f;
#pragma unroll
    for (int q = 0; q < NWAVES; ++q) { const float t = wt[q]; if (q < w) base += t; }
    const float off = base + (inc - tot); float* dst = bias + (size_t)bh * SEQ + 16 * tid;
#pragma unroll
    for (int i = 0; i < 16; i += 4) { f32x4 o; o[0] = -1.4426950408889634f * (off + v[i]); o[1] = -1.4426950408889634f * (off + v[i + 1]); o[2] = -1.4426950408889634f * (off + v[i + 2]); o[3] = -1.4426950408889634f * (off + v[i + 3]); *(f32x4*)(dst + i) = o; }
    __syncthreads();
}
__device__ __forceinline__ void route_block(LAS unsigned char* lds, const float* logits, const float* b_group, const float* b_expert, gu32* gcnt, int* list, int* slot, float* ew, int tok0, int tid) {
    LAS int* lcnt = (LAS int*)lds; LAS int* gbase = lcnt + 32;
    if (tid < 32) lcnt[tid] = 0;
    __syncthreads();
    int e1 = 0, e2 = 0, p1 = 0, p2 = 0; float w1 = 0.f, w2 = 0.f; const int tok = tok0 + tid;
    if (tid < 64) {
        const float* lr = logits + (size_t)tok * 64;
        float gl[4]; int gs = 0; float gmax;
#pragma unroll
        for (int j = 0; j < 4; ++j) gl[j] = lr[j] + b_group[j];
        gmax = gl[0];
#pragma unroll
        for (int j = 1; j < 4; ++j) if (gl[j] > gmax) { gmax = gl[j]; gs = j; }
        float den = 0.f;
#pragma unroll
        for (int j = 0; j < 4; ++j) den += expf(gl[j] - gmax);
        const float gval = 1.0f / den;
        float el[8];
        { const f32x4 ea = *(const f32x4*)(lr + 4 + 8 * gs), eb = *(const f32x4*)(lr + 8 + 8 * gs), ba = *(const f32x4*)(b_expert + 8 * gs), bb = *(const f32x4*)(b_expert + 8 * gs + 4);
#pragma unroll
          for (int j = 0; j < 4; ++j) { el[j] = ea[j] + ba[j]; el[4 + j] = eb[j] + bb[j]; } }
        int i1 = 0; float v1 = el[0];
#pragma unroll
        for (int j = 1; j < 8; ++j) if (el[j] > v1) { v1 = el[j]; i1 = j; }
        int i2 = -1; float v2 = -INFINITY;
#pragma unroll
        for (int j = 0; j < 8; ++j) if (j != i1 && el[j] > v2) { v2 = el[j]; i2 = j; }
        const float t = expf(v2 - v1); w1 = gval / (1.0f + t); w2 = gval * t / (1.0f + t);
        e1 = 8 * gs + i1; e2 = 8 * gs + i2;
        p1 = __hip_atomic_fetch_add(&lcnt[e1], 1, __ATOMIC_RELAXED, __HIP_MEMORY_SCOPE_WORKGROUP); p2 = __hip_atomic_fetch_add(&lcnt[e2], 1, __ATOMIC_RELAXED, __HIP_MEMORY_SCOPE_WORKGROUP);
    }
    __syncthreads();
    if (tid < 32) { const int n = lcnt[tid]; gbase[tid] = n ? (int)__hip_atomic_fetch_add(gcnt + tid, (unsigned)n, RLX_AGENT) : 0; }
    __syncthreads();
    if (tid < 64) {
        p1 += gbase[e1]; p2 += gbase[e2];
        list[(size_t)e1 * LIST_CAP + p1] = tok; list[(size_t)e2 * LIST_CAP + p2] = tok;
        slot[2 * tok] = (e1 << 16) | p1; slot[2 * tok + 1] = (e2 << 16) | p2; ew[2 * tok] = w1; ew[2 * tok + 1] = w2;
    }
    __syncthreads();
}
__device__ __forceinline__ void moe_tables(LAS unsigned char* ldsctl, gu32* gcnt, int tid) {
    LAS int* pfx = (LAS int*)ldsctl; LAS int* cnt = (LAS int*)(ldsctl + 160);
    if (tid < 32) cnt[tid] = (int)__hip_atomic_load(gcnt + tid, RLX_AGENT);
    __syncthreads();
    if (tid == 0) { int a = 0; for (int e = 0; e < 32; ++e) { pfx[e] = a; a += (cnt[e] + 255) >> 8; } pfx[32] = a; }
    __syncthreads();
}
__device__ __forceinline__ void final_rows(float* out, const bf16* YS, const int* slot, const float* ew, const float* mod, const float* fg, const LAS int* pfx, int gw, int NGW, int lane) {
    int curb = -1; f32x4 gm[4][2], gf[4][2];
#pragma unroll
    for (int j = 0; j < 4; ++j) { gf[j][0] = *(const f32x4*)(fg + 8 * lane + 512 * j); gf[j][1] = *(const f32x4*)(fg + 8 * lane + 512 * j + 4); }
    for (int m = gw; m < M; m += NGW) {
        const int b = m >= SEQ ? 1 : 0;
        if (b != curb) { curb = b;
#pragma unroll
            for (int j = 0; j < 4; ++j) { const float* p = mod + b * (6 * DM) + 5 * DM + 8 * lane + 512 * j; gm[j][0] = *(const f32x4*)p; gm[j][1] = *(const f32x4*)(p + 4); } }
        const int s0 = slot[2 * m], s1 = slot[2 * m + 1]; const float w0 = ew[2 * m], w1 = ew[2 * m + 1];
        const size_t r0 = (size_t)(pfx[s0 >> 16] * 256 + (s0 & 0xffff)), r1 = (size_t)(pfx[s1 >> 16] * 256 + (s1 & 0xffff));
        const GAS v4u* y0 = (const GAS v4u*)(YS + r0 * DM) + lane; const GAS v4u* y1 = (const GAS v4u*)(YS + r1 * DM) + lane;
        GAS f32x4* xr = (GAS f32x4*)(out + (size_t)m * DM) + 2 * lane;
        f32x4 v[4][2]; float s = 0.f;
#pragma unroll
        for (int j = 0; j < 4; ++j) { const v4u a = y0[64 * j], c = y1[64 * j]; const f32x4 x0 = xr[128 * j], x1 = xr[128 * j + 1];
            f32x4 ya, yb; ya[0] = w0 * bf_lo(a[0]) + w1 * bf_lo(c[0]); ya[1] = w0 * bf_hi(a[0]) + w1 * bf_hi(c[0]); ya[2] = w0 * bf_lo(a[1]) + w1 * bf_lo(c[1]); ya[3] = w0 * bf_hi(a[1]) + w1 * bf_hi(c[1]);
            yb[0] = w0 * bf_lo(a[2]) + w1 * bf_lo(c[2]); yb[1] = w0 * bf_hi(a[2]) + w1 * bf_hi(c[2]); yb[2] = w0 * bf_lo(a[3]) + w1 * bf_lo(c[3]); yb[3] = w0 * bf_hi(a[3]) + w1 * bf_hi(c[3]);
            v[j][0] = x0 + gm[j][0] * ya; v[j][1] = x1 + gm[j][1] * yb;
#pragma unroll
            for (int q = 0; q < 2; ++q) s += (v[j][q].x * v[j][q].x + v[j][q].y * v[j][q].y) + (v[j][q].z * v[j][q].z + v[j][q].w * v[j][q].w); }
        const float rstd = 1.0f / sqrtf(wave_sum(s) * (1.0f / DM) + EPS);
#pragma unroll
        for (int j = 0; j < 4; ++j) { xr[128 * j] = v[j][0] * rstd * gf[j][0]; xr[128 * j + 1] = v[j][1] * rstd * gf[j][1]; }
    }
}

struct Args { const float* in[20]; float* out; unsigned char* ws; int ph_lo, ph_hi, li, pad; };
__global__ void __launch_bounds__(NWAVES * 64, 2) fwd_kernel(Args args) {
    extern __shared__ __attribute__((aligned(16))) unsigned char lds_raw[];
    LAS unsigned char* lds = (LAS unsigned char*)lds_raw;
    volatile LAS unsigned* MISC = (volatile LAS unsigned*)(lds + MISC_OFF);
    const int tid = threadIdx.x, lane = tid & 63, wave = __builtin_amdgcn_readfirstlane(tid >> 6);
    const int G = gridDim.x; const int bx = blockIdx.x; const int vcu = (G % 8 == 0) ? (bx % 8) * (G / 8) + bx / 8 : bx;
    const int gw = vcu * NWAVES + wave, NGW = G * NWAVES;
    typedef const __attribute__((address_space(4))) Args* kargp_t;
#define KP() ({ kargp_t kp_ = (kargp_t)__builtin_amdgcn_kernarg_segment_ptr(); asm volatile("" : "+s"(kp_)); kp_; })
#define WSP(kp, off) (kp->ws + (off))
    gu32* ctl = (gu32*)(args.ws + WS_CTL);
    for (int u = tid; u < (LDS_BYTES - LDSCTL_OFF) / 4; u += NWAVES * 64) ((LAS unsigned*)(lds + LDSCTL_OFF))[u] = 0u;
    __syncthreads();
    XcdBarrier bar; bar.bar = (unsigned*)(ctl + CW_BAR); bar.x = 0; bar.st = nullptr;
    if (N_LAUNCHES != PER_PHASE) bar = xcd_barrier_post((unsigned*)(ctl + CW_BAR), MISC + 8);
#define GRID_BAR(seam) do { if (N_LAUNCHES == PER_PHASE) { if (tid == 0) __hip_atomic_store(ctl + CW_TMO, 0xBADBA0u | (unsigned)(seam), RLX_AGENT); } else { xcd_barrier(bar); } } while (0)
    const int lo = args.ph_lo, hi = args.ph_hi;
#ifndef PH_MASK
#define PH_MASK 0x1fff
#endif
#define IN(k) ((((PH_MASK) >> (k)) & 1) && lo <= (k) && (k) < hi)
#define BOTH(k) (IN(k) && IN((k) + 1))

    if (IN(0)) {
        kargp_t kp = KP();
        const float *cvec = kp->in[1], *w_ada = kp->in[2], *b_ada = kp->in[3], *w_in = kp->in[5], *w_out = kp->in[10], *w_group = kp->in[12], *w_expert = kp->in[14], *w_gate = kp->in[16], *w_up = kp->in[17], *w_down = kp->in[18];
        unsigned char* ws = kp->ws; float* MOD = (float*)(ws + WS_MOD);
        bf16 *WR = (bf16*)(ws + WS_WR), *WIN = (bf16*)(ws + WS_WIN), *WOUT = (bf16*)(ws + WS_WOUT), *WGU = (bf16*)(ws + WS_WGU), *WDN = (bf16*)(ws + WS_WDN);
        for (int it = bx; it < (6 * DM) / 64; it += G) p0_mod_item(lds, cvec, w_ada, b_ada, MOD, it, tid);
        LAS float* scr = (LAS float*)(lds + RING_OFF + wave * 16384);
        constexpr int I_IN = 32 * 152, I_OUT = 32 * 64, I_G = 32 * 512, I_D = 32 * 512, NITEMS = I_IN + I_OUT + 2 * I_G + I_D;
        for (int it = gw; it < NITEMS; it += NGW) {
            int r = it;
            if (r < I_IN) { const int kb = r / 152, nb = r % 152; tr_item(w_in, NCOLS_IN, 64 * kb, 32 * nb, WIN + (size_t)(32 * nb) * DM, DM, scr, lane); continue; } r -= I_IN;
            if (r < I_OUT) { const int kb = r / 64, nb = r % 64; tr_item(w_out, DM, 64 * kb, 32 * nb, WOUT + (size_t)(32 * nb) * DM, DM, scr, lane); continue; } r -= I_OUT;
            if (r < 2 * I_G) { const int up = r >= I_G ? 1 : 0; r -= up * I_G; const int e = r / 512, q = r % 512, kb = q / 16, n0 = 32 * (q % 16), drow = 256 * (n0 >> 7) + (n0 & 127) + 128 * up;
                tr_item((up ? w_up : w_gate) + (size_t)e * DM * DEXP, DEXP, 64 * kb, n0, WGU + ((size_t)e * 1024 + drow) * DM, DM, scr, lane); continue; } r -= 2 * I_G;
            { const int e = r / 512, q = r % 512, kb = q / 64, n0 = 32 * (q % 64); tr_item(w_down + (size_t)e * DEXP * DM, DM, 64 * kb, n0, WDN + ((size_t)e * DM + n0) * DEXP, DEXP, scr, lane); }
        }
        for (int idx = gw * 64 + lane; idx < 256 * 256; idx += NGW * 64) {
            const int r = idx >> 8, k0 = (idx & 255) * 8; float v[8];
#pragma unroll
            for (int j = 0; j < 8; ++j) v[j] = r < 4 ? w_group[(k0 + j) * 4 + r] : (r < 36 ? w_expert[(k0 + j) * 32 + (r - 4)] : 0.f);
            v4u o; o.x = pk2(v[0], v[1]); o.y = pk2(v[2], v[3]); o.z = pk2(v[4], v[5]); o.w = pk2(v[6], v[7]); *(GAS v4u*)(WR + (size_t)r * DM + k0) = o;
        }
        if (BOTH(0)) GRID_BAR(0);
    }
    if (IN(1)) { kargp_t kp = KP(); norm_mod_rows(kp->in[0], kp->in[4], (const float*)WSP(kp, WS_MOD), 0, 1, (bf16*)WSP(kp, WS_XN), gw, NGW, lane); if (BOTH(1)) GRID_BAR(1); }
    if (IN(2)) {
        kargp_t kp = KP();
        pg8::Gemm g{(const bf16*)WSP(kp, WS_XN), (const bf16*)WSP(kp, WS_WIN), DM, DM}; pg8::StaticOrder S; S.init(M, NPROJ, G, bx);
        pg8::EpiProj E{(bf16*)WSP(kp, WS_PROJ), (float*)WSP(kp, WS_LOGF), kp->in[6], attn_body::C2};
        pg8::gemm_phase<pg8::EpiProj, pg8::StaticOrder, true>(lds + RING_OFF, g, S, E);
        if (BOTH(2)) GRID_BAR(2);
    }
    if (IN(3)) { kargp_t kp = KP(); for (int bh = bx; bh < 32; bh += G) scan_seq(lds, (const float*)WSP(kp, WS_LOGF), (float*)WSP(kp, WS_BIAS), bh, tid); if (BOTH(3)) GRID_BAR(3); }
    if (IN(4)) {
        kargp_t kp = KP();
        const attn_body::AttnArgs AT{(const attn_body::bf16*)WSP(kp, WS_PROJ), (attn_body::bf16*)WSP(kp, WS_OBUF), (const float*)WSP(kp, WS_BIAS), kp->in[7]};
        attn_body::attn_phase<8>((char*)lds_raw + RING_OFF, AT, vcu, G);
        if (BOTH(4)) GRID_BAR(4);
    }
    if (IN(5)) { kargp_t kp = KP(); onorm_rows((bf16*)WSP(kp, WS_OBUF), kp->in[8], kp->in[9], gw, NGW, lane); if (BOTH(5)) GRID_BAR(5); }
    if (IN(6)) {
        kargp_t kp = KP();
        pg8::Gemm g{(const bf16*)WSP(kp, WS_OBUF), (const bf16*)WSP(kp, WS_WOUT), DM, DM}; pg8::StaticOrder S; S.init(M, DM, G, bx);
        pg8::EpiResGate E{kp->in[0], kp->out, (const float*)WSP(kp, WS_MOD)};
        pg8::gemm_phase<pg8::EpiResGate, pg8::StaticOrder, true>(lds + RING_OFF, g, S, E);
        if (BOTH(6)) GRID_BAR(6);
    }
    if (IN(7)) { kargp_t kp = KP(); norm_mod_rows(kp->out, kp->in[11], (const float*)WSP(kp, WS_MOD), 3, 4, (bf16*)WSP(kp, WS_XN), gw, NGW, lane); if (BOTH(7)) GRID_BAR(7); }
    if (IN(8)) {
        kargp_t kp = KP();
        pg8::Gemm g{(const bf16*)WSP(kp, WS_XN), (const bf16*)WSP(kp, WS_WR), DM, DM}; pg8::StaticOrder S; S.init(M, 256, G, bx);
        pg8::EpiRouter E{(float*)WSP(kp, WS_LOGITS)};
        pg8::gemm_phase<pg8::EpiRouter, pg8::StaticOrder, true>(lds + RING_OFF, g, S, E);
        if (BOTH(8)) GRID_BAR(8);
    }
    if (IN(9)) { kargp_t kp = KP();
        for (int t0 = bx * 64; t0 < M; t0 += G * 64) route_block(lds, (const float*)WSP(kp, WS_LOGITS), kp->in[13], kp->in[15], (gu32*)WSP(kp, WS_CTL) + CW_CNT, (int*)WSP(kp, WS_LIST), (int*)WSP(kp, WS_SLOT), (float*)WSP(kp, WS_EW), t0, tid);
        if (BOTH(9)) GRID_BAR(9); }
    if (IN(10)) {
        kargp_t kp = KP();
        moe_tables(lds + LDSCTL_OFF, (gu32*)WSP(kp, WS_CTL) + CW_CNT, tid);
        pg8::Gemm g{(const bf16*)WSP(kp, WS_XN), (const bf16*)WSP(kp, WS_WGU), DM, DM}; pg8::GroupedOrder S{(const LAS int*)(lds + LDSCTL_OFF), (const LAS int*)(lds + LDSCTL_OFF + 160), (const int*)WSP(kp, WS_LIST), 4, G, bx};
        pg8::EpiSwiGLU E{(bf16*)WSP(kp, WS_HID)};
        pg8::gemm_phase<pg8::EpiSwiGLU, pg8::GroupedOrder, true>(lds + RING_OFF, g, S, E);
        if (BOTH(10)) GRID_BAR(10);
    }
    if (IN(11)) {
        kargp_t kp = KP();
        moe_tables(lds + LDSCTL_OFF, (gu32*)WSP(kp, WS_CTL) + CW_CNT, tid);
        pg8::Gemm g{(const bf16*)WSP(kp, WS_HID), (const bf16*)WSP(kp, WS_WDN), DEXP, DEXP}; pg8::GroupedOrder S{(const LAS int*)(lds + LDSCTL_OFF), (const LAS int*)(lds + LDSCTL_OFF + 160), nullptr, 8, G, bx};
        pg8::EpiDown E{(bf16*)WSP(kp, WS_YS)};
        pg8::gemm_phase<pg8::EpiDown, pg8::GroupedOrder, true>(lds + RING_OFF, g, S, E);
        if (BOTH(11)) GRID_BAR(11);
    }
    if (IN(12)) {
        kargp_t kp = KP();
        moe_tables(lds + LDSCTL_OFF, (gu32*)WSP(kp, WS_CTL) + CW_CNT, tid);
        const unsigned bad = __hip_atomic_load(ctl + CW_TMO, RLX_AGENT) | __hip_atomic_load((gu32*)((unsigned*)(ctl + CW_BAR) + XB_TMO), RLX_AGENT);
        float* out = kp->out;
        final_rows(out, (const bf16*)WSP(kp, WS_YS), (const int*)WSP(kp, WS_SLOT), (const float*)WSP(kp, WS_EW), (const float*)WSP(kp, WS_MOD), kp->in[19], (const LAS int*)(lds + LDSCTL_OFF), gw, NGW, lane);
        if (bad && N_LAUNCHES != PER_PHASE) { const float qn = __builtin_nanf(""); for (int m = gw; m < M; m += NGW) out[(size_t)m * DM + lane] = qn; }
    }
#undef IN
#undef BOTH
}

extern "C" void kernel_launch(void* const* d_in, const int* in_sizes, int n_in, void* d_out, int out_size, void* d_ws, size_t ws_size, hipStream_t stream) {
    static int grid = 0;
    if (grid == 0) {
        if (n_in != 20 || in_sizes[0] != M * DM || out_size != M * DM || ws_size < WS_END) { fprintf(stderr, "kernel_launch: unexpected shapes or workspace (n_in %d, in0 %d, out %d, ws %zu < %zu); nothing launched\n", n_in, n_in > 0 ? in_sizes[0] : -1, out_size, ws_size, (size_t)WS_END); grid = -1; return; }
        int dev = 0, cus = 0, per_cu = 0;
        if (hipGetDevice(&dev) != hipSuccess || hipDeviceGetAttribute(&cus, hipDeviceAttributeMultiprocessorCount, dev) != hipSuccess) { fprintf(stderr, "kernel_launch: device query failed\n"); grid = -1; return; }
        if (hipFuncSetAttribute((const void*)fwd_kernel, hipFuncAttributeMaxDynamicSharedMemorySize, LDS_BYTES) != hipSuccess) { fprintf(stderr, "kernel_launch: hipFuncSetAttribute failed\n"); grid = -1; return; }
        if (hipOccupancyMaxActiveBlocksPerMultiprocessor(&per_cu, (const void*)fwd_kernel, NWAVES * 64, LDS_BYTES) != hipSuccess || per_cu < 1) fprintf(stderr, "kernel_launch: note: occupancy query reports %d workgroups per CU\n", per_cu);
        (void)hipGetLastError();
        grid = cus;
    }
    if (grid < 0) return;
    if (hipMemsetAsync((char*)d_ws + WS_CTL, 0, CTL_ZERO_BYTES, stream) != hipSuccess) { fprintf(stderr, "kernel_launch: hipMemsetAsync failed\n"); return; }
    Args a{};
    for (int i = 0; i < 20; ++i) a.in[i] = (const float*)d_in[i];
    a.out = (float*)d_out; a.ws = (unsigned char*)d_ws;
    for (int li = 0; li < N_LAUNCHES; ++li) {
        a.ph_lo = (N_LAUNCHES == PER_PHASE) ? li : 0; a.ph_hi = (N_LAUNCHES == PER_PHASE) ? li + 1 : PER_PHASE; a.li = li;
        hipLaunchKernelGGL(fwd_kernel, dim3(grid), dim3(NWAVES * 64), LDS_BYTES, stream, a);
        const hipError_t le = hipPeekAtLastError();
        if (le != hipSuccess) { fprintf(stderr, "kernel_launch: launch %d failed: %s\n", li, hipGetErrorName(le)); break; }
    }
}
```

```cpp
#include <hip/hip_runtime.h>
#include <hip/hip_bf16.h>
#include <cstdio>
#include <cstdint>
#include <cmath>
namespace pg8 {
#define PG8_LAS __attribute__((address_space(3)))
typedef unsigned short bf16_t;
typedef short bf16x8 __attribute__((ext_vector_type(8)));
typedef float f32x4 __attribute__((ext_vector_type(4)));
typedef unsigned u32x4 __attribute__((ext_vector_type(4)));
constexpr int BM = 256, BK = 64, HALF = 128, HTB = HALF * BK * 2  , STAGE_BYTES = 8 * HTB, NXCD = 8, WGM = 8;
constexpr int LIST_CAP = 16384;

__host__ __device__ __forceinline__ int lds_byte(int r, int c) { const int st = (r >> 4) * 2 + (c >> 5), rr = r & 15, cc = c & 31, ob = rr * 64 + cc * 2; return st * 1024 + (ob ^ (((ob >> 9) & 1) << 5)); }
__host__ __device__ __forceinline__ void stage_rc(int b, int& R, int& C) { const int st = b / 1024, sb = b % 1024, swz = sb ^ (((sb >> 9) & 1) << 5); R = (st >> 1) * 16 + swz / 64; C = (st & 1) * 32 + (swz % 64) / 2; }
__host__ __device__ __forceinline__ int perm32(int rho) { const int n = rho >> 4, i = rho & 15; return 8 * (i >> 2) + 4 * n + (i & 3); }

struct Unit { int pm, pn, e, pl, nv; };
struct Gemm { const bf16_t* A; const bf16_t* Bt; int lda, K; };

struct StaticOrder {
    int nM, nN, nwg, G, c;
    __host__ __device__ void init(int M, int N, int G_, int c_) { nM = M / BM; nN = N / BM; nwg = nM * nN; G = G_; c = c_; }
    __host__ __device__ bool next(int i, Unit& u) const {
        const long L = (long)i * G + c; if (L >= nwg) return false;
        int wgid = (int)L; { const int q = nwg / NXCD, r = nwg % NXCD, xcd = wgid % NXCD, off = wgid / NXCD; wgid = (xcd < r ? xcd * (q + 1) : r * (q + 1) + (xcd - r) * q) + off; }
        const int nig = WGM * nN, gid = wgid / nig, fm = gid * WGM, gsz = (nM - fm) < WGM ? (nM - fm) : WGM;
        u.pm = fm + ((wgid % nig) % gsz); u.pn = (wgid % nig) / gsz; u.e = 0; u.pl = 0; u.nv = BM; return true;
    }
    __device__ __forceinline__ int arow(const Unit& u, int r) const { return u.pm * BM + r; }
    __device__ __forceinline__ void a_ready(const Unit&) const {}
    __device__ __forceinline__ void done(const Unit&) const {}
};
struct GroupedOrder {
    const PG8_LAS int* pfx; const PG8_LAS int* cnt; const int* list; int ntile, G, c;
    __device__ __forceinline__ bool next(int i, Unit& u) const {
        const int total = __builtin_amdgcn_readfirstlane(pfx[32]) * ntile; const long L = (long)i * G + c; if (L >= total) return false;
        const int pg = (int)L / ntile, pnl = (int)L % ntile; int e = 0;
#pragma unroll 8
        for (int j = 1; j < 32; ++j) e += (pg >= pfx[j]) ? 1 : 0;
        e = __builtin_amdgcn_readfirstlane(e);
        const int pl = pg - __builtin_amdgcn_readfirstlane(pfx[e]); const int rem = __builtin_amdgcn_readfirstlane(cnt[e]) - BM * pl;
        u.pm = pg; u.pn = e * ntile + pnl; u.e = e; u.pl = pl; u.nv = rem < BM ? rem : BM; return true;
    }
    __device__ __forceinline__ int arow(const Unit& u, int r) const { return list ? list[(size_t)u.e * LIST_CAP + u.pl * BM + (r < u.nv ? r : 0)] : u.pm * BM + r; }
    __device__ __forceinline__ void a_ready(const Unit&) const {}
    __device__ __forceinline__ void done(const Unit&) const {}
};

__device__ __forceinline__ unsigned cvt_pk_bf16(float lo, float hi) { unsigned r; asm volatile("v_cvt_pk_bf16_f32 %0, %1, %2" : "=v"(r) : "v"(lo), "v"(hi)); return r; }
__device__ __forceinline__ float log_sigmoid(float x) { return fminf(x, 0.f) - log1pf(expf(-fabsf(x))); }
__device__ __forceinline__ float silu_f(float g) { return g * __builtin_amdgcn_rcpf(1.0f + __builtin_amdgcn_exp2f(-1.4426950408889634f * g)); }

struct EpiProj {
    static constexpr bool PERM = true, AFTER_DRAIN = false;
    bf16_t* P; float* logf; const float* bfg; float qscale;
    __device__ __forceinline__ void operator()(const f32x4 (&acc)[2][2][4][2], const Unit& u, int wr, int wc, int fr, int fq) const {
        const int row0 = u.pm * BM + wr * 64 + fr;
        if (u.pn < 18) {
            const float sc = (u.pn < 4 || (u.pn >= 6 && u.pn < 10)) ? qscale : 1.f;
            const int col0 = u.pn * BM + wc * 32 + 8 * fq;
#pragma unroll
            for (int ai = 0; ai < 2; ++ai)
#pragma unroll
                for (int m = 0; m < 4; ++m) { bf16_t* rowp = P + (size_t)(row0 + ai * HALF + m * 16) * 4608 + col0;
#pragma unroll
                    for (int bj = 0; bj < 2; ++bj) { const f32x4 v0 = acc[ai][bj][m][0] * sc, v1 = acc[ai][bj][m][1] * sc;
                        u32x4 w; w.x = cvt_pk_bf16(v0[0], v0[1]); w.y = cvt_pk_bf16(v0[2], v0[3]); w.z = cvt_pk_bf16(v1[0], v1[1]); w.w = cvt_pk_bf16(v1[2], v1[3]);
                        *(u32x4*)(rowp + bj * HALF) = w; } }
        } else if (wc == 0 && fq < 2) {
#pragma unroll
            for (int n = 0; n < 2; ++n) { const int c0 = 8 * fq + 4 * n; const f32x4 bv = *(const f32x4*)(bfg + c0);
#pragma unroll
                for (int ai = 0; ai < 2; ++ai)
#pragma unroll
                    for (int m = 0; m < 4; ++m) { const f32x4 v = acc[ai][0][m][n] + bv; f32x4 o; o[0] = log_sigmoid(v[0]); o[1] = log_sigmoid(v[1]); o[2] = log_sigmoid(v[2]); o[3] = log_sigmoid(v[3]);
                        *(f32x4*)(logf + (size_t)(row0 + ai * HALF + m * 16) * 16 + c0) = o; } }
        }
    }
};
struct EpiResGate {
    static constexpr bool PERM = false, AFTER_DRAIN = false;
    const float* x; float* out; const float* mod;
    __device__ __forceinline__ void operator()(const f32x4 (&acc)[2][2][4][2], const Unit& u, int wr, int wc, int fr, int fq) const {
        const float* g = mod + (u.pm >= 32 ? 12288 : 0) + 2 * 2048; const int col0 = u.pn * BM + wc * 32 + 4 * fq;
        f32x4 gv[2][2];
#pragma unroll
        for (int bj = 0; bj < 2; ++bj)
#pragma unroll
            for (int n = 0; n < 2; ++n) gv[bj][n] = *(const f32x4*)(g + col0 + bj * HALF + n * 16);
#pragma unroll
        for (int ai = 0; ai < 2; ++ai)
#pragma unroll
            for (int m = 0; m < 4; ++m) { const size_t off = (size_t)(u.pm * BM + ai * HALF + wr * 64 + m * 16 + fr) * 2048 + col0;
#pragma unroll
                for (int bj = 0; bj < 2; ++bj)
#pragma unroll
                    for (int n = 0; n < 2; ++n) { const f32x4 xv = *(const f32x4*)(x + off + bj * HALF + n * 16); *(f32x4*)(out + off + bj * HALF + n * 16) = xv + gv[bj][n] * acc[ai][bj][m][n]; }
                asm volatile("" ::: "memory"); }
    }
};
struct EpiRouter {
    static constexpr bool PERM = false, AFTER_DRAIN = false;
    float* L;
    __device__ __forceinline__ void operator()(const f32x4 (&acc)[2][2][4][2], const Unit& u, int wr, int wc, int fr, int fq) const {
        if (wc < 2) {
#pragma unroll
            for (int ai = 0; ai < 2; ++ai)
#pragma unroll
                for (int m = 0; m < 4; ++m) { float* rp = L + (size_t)(u.pm * BM + ai * HALF + wr * 64 + m * 16 + fr) * 64 + wc * 32 + 4 * fq;
#pragma unroll
                    for (int n = 0; n < 2; ++n) *(f32x4*)(rp + n * 16) = acc[ai][0][m][n]; }
        }
    }
};
struct EpiSwiGLU {
    static constexpr bool PERM = true, AFTER_DRAIN = false;
    bf16_t* H;
    __device__ __forceinline__ void operator()(const f32x4 (&acc)[2][2][4][2], const Unit& u, int wr, int wc, int fr, int fq) const {
        const int col0 = (u.pn & 3) * 128 + wc * 32 + 8 * fq;
#pragma unroll
        for (int ai = 0; ai < 2; ++ai)
#pragma unroll
            for (int m = 0; m < 4; ++m) { bf16_t* rowp = H + (size_t)(u.pm * BM + ai * HALF + wr * 64 + m * 16 + fr) * 512 + col0;
                const f32x4 g0 = acc[ai][0][m][0], g1 = acc[ai][0][m][1], u0 = acc[ai][1][m][0], u1 = acc[ai][1][m][1];
                u32x4 w; w.x = cvt_pk_bf16(silu_f(g0[0]) * u0[0], silu_f(g0[1]) * u0[1]); w.y = cvt_pk_bf16(silu_f(g0[2]) * u0[2], silu_f(g0[3]) * u0[3]);
                w.z = cvt_pk_bf16(silu_f(g1[0]) * u1[0], silu_f(g1[1]) * u1[1]); w.w = cvt_pk_bf16(silu_f(g1[2]) * u1[2], silu_f(g1[3]) * u1[3]);
                *(u32x4*)rowp = w; }
    }
};
struct EpiDown {
    static constexpr bool PERM = true, AFTER_DRAIN = false;
    bf16_t* Y;
    __device__ __forceinline__ void operator()(const f32x4 (&acc)[2][2][4][2], const Unit& u, int wr, int wc, int fr, int fq) const {
        const int col0 = (u.pn & 7) * BM + wc * 32 + 8 * fq;
#pragma unroll
        for (int ai = 0; ai < 2; ++ai)
#pragma unroll
            for (int m = 0; m < 4; ++m) { bf16_t* rowp = Y + (size_t)(u.pm * BM + ai * HALF + wr * 64 + m * 16 + fr) * 2048 + col0;
#pragma unroll
                for (int bj = 0; bj < 2; ++bj) { const f32x4 v0 = acc[ai][bj][m][0], v1 = acc[ai][bj][m][1];
                    u32x4 w; w.x = cvt_pk_bf16(v0[0], v0[1]); w.y = cvt_pk_bf16(v0[2], v0[3]); w.z = cvt_pk_bf16(v1[0], v1[1]); w.w = cvt_pk_bf16(v1[2], v1[3]);
                    *(u32x4*)(rowp + bj * HALF) = w; } }
    }
};

template <class Epi, class Sched, bool ALIGN_EPI>
__device__ __forceinline__ void gemm_phase(PG8_LAS unsigned char* lds, const Gemm g, const Sched& S, const Epi& E) {
    const int tid = threadIdx.x, wid = __builtin_amdgcn_readfirstlane(tid >> 6), lane = tid & 63, wr = wid >> 2, wc = wid & 3, fr = lane & 15, fq = lane >> 4;
    const int K = g.K, nt = K / BK, lda = g.lda;
    int RA[2], CA[2]; unsigned voffB[2];
#pragma unroll
    for (int i = 0; i < 2; ++i) { int R, C; stage_rc(tid * 16 + i * 8192, R, C); const int Rb = Epi::PERM ? ((R & ~31) + perm32(R & 31)) : R;
        RA[i] = R; CA[i] = C; voffB[i] = (unsigned)(Rb * K + C) * 2u; }
    const size_t kstep = (size_t)(BK * 2);
    const size_t hstep = (size_t)HALF * K * 2;
    const size_t tstep = 2 * hstep;
    const unsigned ldsw = (unsigned)wid * 1024u;
    const int aoff = lds_byte(wr * 64 + fr, fq * 8), boff = lds_byte(wc * 32 + fr, fq * 8);
    const char* const Ab = (const char*)g.A;
#define PG8_SA(b, h) (((b) * 2 + (h)) * HTB)
#define PG8_SB(b, h) ((4 + (b) * 2 + (h)) * HTB)
#define PG8_STAGE(bufoff, gbase, voff) do { _Pragma("unroll") for (int _i = 0; _i < 2; ++_i) \
        __builtin_amdgcn_global_load_lds((const unsigned*)((const char*)(gbase) + (voff)[_i]), (PG8_LAS unsigned*)(lds + (bufoff) + ldsw + _i * 8192), 16, 0, 0); } while (0)
#define PG8_LDA(dst, b, h) do { _Pragma("unroll") for (int m = 0; m < 4; ++m) _Pragma("unroll") for (int k = 0; k < 2; ++k) dst[m][k] = *(const PG8_LAS bf16x8*)(lds + PG8_SA(b, h) + aoff + m * 2048 + k * 1024); } while (0)
#define PG8_LDB(dst, b, h) do { _Pragma("unroll") for (int n = 0; n < 2; ++n) _Pragma("unroll") for (int k = 0; k < 2; ++k) dst[n][k] = *(const PG8_LAS bf16x8*)(lds + PG8_SB(b, h) + boff + n * 2048 + k * 1024); } while (0)
#define PG8_MMA(ai, bj, At, Bt) do { __builtin_amdgcn_s_setprio(1); _Pragma("unroll") for (int m = 0; m < 4; ++m) _Pragma("unroll") for (int n = 0; n < 2; ++n) _Pragma("unroll") for (int k = 0; k < 2; ++k) \
        acc[ai][bj][m][n] = __builtin_amdgcn_mfma_f32_16x16x32_bf16(Bt[n][k], At[m][k], acc[ai][bj][m][n], 0, 0, 0); __builtin_amdgcn_s_setprio(0); } while (0)
#define PG8_WAIT_V(n) asm volatile("s_waitcnt vmcnt(" #n ")" ::: "memory")
#define PG8_WAIT_L(n) asm volatile("s_waitcnt lgkmcnt(" #n ")" ::: "memory")
#define PG8_BAR __builtin_amdgcn_s_barrier()
#define PG8_SCHED __builtin_amdgcn_sched_barrier(0)
#define PG8_AOFF(dst, u) do { _Pragma("unroll") for (int _h = 0; _h < 2; ++_h) _Pragma("unroll") for (int _i = 0; _i < 2; ++_i) \
        dst[_h][_i] = ((unsigned)S.arow(u, _h * HALF + RA[_i]) * (unsigned)lda + (unsigned)CA[_i]) * 2u; } while (0)
    Unit cur, nxt; int ui = 0;
    if (!S.next(0, cur)) return;
    f32x4 acc[2][2][4][2];
#pragma unroll
    for (int a = 0; a < 2; ++a)
#pragma unroll
        for (int b = 0; b < 2; ++b)
#pragma unroll
            for (int m = 0; m < 4; ++m)
#pragma unroll
                for (int n = 0; n < 2; ++n) acc[a][b][m][n] = (f32x4){0.f, 0.f, 0.f, 0.f};
    bf16x8 At[4][2], B0[2][2], B1[2][2];
    unsigned ca[2][2], na[2][2];
    PG8_AOFF(ca, cur);
    const char* cB = (const char*)g.Bt + (size_t)cur.pn * tstep;
    S.a_ready(cur);
    PG8_STAGE(PG8_SB(0, 0), cB, voffB); PG8_STAGE(PG8_SB(0, 1), cB + hstep, voffB); PG8_STAGE(PG8_SA(0, 0), Ab, ca[0]); PG8_STAGE(PG8_SA(0, 1), Ab, ca[1]);
    if (wr == 1) PG8_BAR;
    PG8_WAIT_V(2); PG8_BAR;
    PG8_STAGE(PG8_SB(1, 0), cB + kstep, voffB); PG8_STAGE(PG8_SA(1, 0), Ab + kstep, ca[0]); PG8_STAGE(PG8_SB(1, 1), cB + hstep + kstep, voffB);
    PG8_WAIT_V(6); PG8_BAR;
    for (;;) {
        const bool has_next = S.next(ui + 1, nxt);
        if (has_next) { PG8_AOFF(na, nxt); } else { na[0][0] = ca[0][0]; na[0][1] = ca[0][1]; na[1][0] = ca[1][0]; na[1][1] = ca[1][1]; }
        const char* nB = has_next ? (const char*)g.Bt + (size_t)nxt.pn * tstep : cB;
        for (int t = 0; t < nt; t += 2) {
            const bool last = (t == nt - 2);
            const char* a1 = Ab + (size_t)(t + 1) * kstep;
            const char* a2 = last ? Ab : Ab + (size_t)(t + 2) * kstep; const char* b2 = last ? nB : cB + (size_t)(t + 2) * kstep;
            const char* a3 = a2 + kstep; const char* b3 = b2 + kstep;
            unsigned o0[2], o1[2]; o0[0] = last ? na[0][0] : ca[0][0]; o0[1] = last ? na[0][1] : ca[0][1]; o1[0] = last ? na[1][0] : ca[1][0]; o1[1] = last ? na[1][1] : ca[1][1];
            if (last && has_next) S.a_ready(nxt);
            PG8_LDB(B0, 0, 0); PG8_LDB(B1, 0, 1); PG8_SCHED; PG8_LDA(At, 0, 0); PG8_STAGE(PG8_SA(1, 1), a1, ca[1]);
            PG8_WAIT_V(8); PG8_WAIT_L(0); PG8_BAR; PG8_MMA(0, 0, At, B0); PG8_MMA(0, 1, At, B1); PG8_BAR; PG8_SCHED;
            PG8_LDA(At, 0, 1); PG8_STAGE(PG8_SB(0, 0), b2, voffB); PG8_STAGE(PG8_SB(0, 1), b2 + hstep, voffB); PG8_STAGE(PG8_SA(0, 0), a2, o0);
            PG8_WAIT_V(8); PG8_WAIT_L(0); PG8_BAR; PG8_MMA(1, 0, At, B0); PG8_MMA(1, 1, At, B1); PG8_BAR; PG8_SCHED;
            PG8_LDB(B0, 1, 0); PG8_LDB(B1, 1, 1); PG8_SCHED; PG8_LDA(At, 1, 0); PG8_STAGE(PG8_SA(0, 1), a2, o1);
            PG8_WAIT_V(8); PG8_WAIT_L(0); PG8_BAR; PG8_MMA(0, 0, At, B0); PG8_MMA(0, 1, At, B1); PG8_BAR; PG8_SCHED;
            PG8_LDA(At, 1, 1); PG8_STAGE(PG8_SB(1, 0), b3, voffB); PG8_STAGE(PG8_SB(1, 1), b3 + hstep, voffB); PG8_STAGE(PG8_SA(1, 0), a3, o0);
            PG8_WAIT_V(8); PG8_WAIT_L(0); PG8_BAR; PG8_MMA(1, 0, At, B0); PG8_MMA(1, 1, At, B1); PG8_BAR; PG8_SCHED;
        }
        if constexpr (ALIGN_EPI) { if (wr == 0) PG8_BAR; }
        E(acc, cur, wr, wc, fr, fq); S.done(cur);
        if (!has_next) break;
#pragma unroll
        for (int a = 0; a < 2; ++a)
#pragma unroll
            for (int b = 0; b < 2; ++b)
#pragma unroll
                for (int m = 0; m < 4; ++m)
#pragma unroll
                    for (int n = 0; n < 2; ++n) acc[a][b][m][n] = (f32x4){0.f, 0.f, 0.f, 0.f};
        cur = nxt; cB = nB; ++ui; ca[0][0] = na[0][0]; ca[0][1] = na[0][1]; ca[1][0] = na[1][0]; ca[1][1] = na[1][1];
        if constexpr (ALIGN_EPI) { if (wr == 1) PG8_BAR; }
    }
    PG8_WAIT_V(0);
    if constexpr (!ALIGN_EPI) { if (wr == 0) PG8_BAR; }
    PG8_BAR;
#undef PG8_SA
#undef PG8_SB
#undef PG8_STAGE
#undef PG8_LDA
#undef PG8_LDB
#undef PG8_MMA
#undef PG8_WAIT_V
#undef PG8_WAIT_L
#undef PG8_BAR
#undef PG8_SCHED
#undef PG8_AOFF
}
}
#include <hip/hip_bf16.h>
#include <cmath>
namespace attn_body {
using bf16=__hip_bfloat16;
using bf16x8=__attribute__((ext_vector_type(8)))short;
using s16x4=__attribute__((ext_vector_type(4)))short;
using f32x16=__attribute__((ext_vector_type(16)))float;
using u32x4=__attribute__((ext_vector_type(4)))unsigned;
constexpr int BATCH=2,NHEAD=16,SEQ=8192,D=64,PP=4608,OP=2048;
constexpr int NW=8,QBLK=32,QB=QBLK*NW,KVBLK=64,NQB=SEQ/QB;
constexpr int ATTN_UNIT_ROWS=QB;
__device__ __forceinline__ int crow(int r,int hi){return (r&3)+8*(r>>2)+4*hi;}
#define SBAR() __builtin_amdgcn_sched_barrier(0)
__device__ __forceinline__ void cmask(f32x16&p0,f32x16&p1,int jb,int qrel,int hi){
  const float NEG=-INFINITY; int kb=64*jb+4*hi;
  #pragma unroll
  for(int r=0;r<16;++r){int kv=kb+(r&3)+8*(r>>2); if(kv>qrel)p0[r]=NEG; if(kv+32>qrel)p1[r]=NEG;}
}

typedef float f32x4v __attribute__((ext_vector_type(4)));
__device__ __forceinline__ void swamask(f32x16&p0,f32x16&p1,int kb0,int qrel,int hi){
  const float NEG=-INFINITY; const int d0=qrel-kb0-4*hi;
  #pragma unroll
  for(int r=0;r<16;++r){const int d=d0-((r&3)+8*(r>>2)); if((unsigned)d>=128u)p0[r]=NEG; if((unsigned)(d-32)>=128u)p1[r]=NEG;}
}
constexpr int NSLOT=3, SLOTB=8192;
constexpr int LDS_K=0, LDS_V=NSLOT*SLOTB, LDS_WS=2*NSLOT*SLOTB, LDS_OST=LDS_WS+NW*64*4, LDS_BIAS=LDS_OST+NW*4096, LDS_MISC=LDS_BIAS+SEQ*4, LDS_BYTES=LDS_MISC+128;
constexpr float C2=0.125f*1.4426950408889634f;
__device__ __forceinline__ void glds16(const void*gsrc,unsigned lds_dst){unsigned keep;
  asm volatile("s_mov_b32 %0, m0\n\ts_mov_b32 m0, %2\n\ts_nop 0\n\tglobal_load_lds_dwordx4 %1, off\n\ts_mov_b32 m0, %0":"=&s"(keep):"v"(gsrc),"s"(lds_dst):"memory");}
__device__ __forceinline__ float max3f(float a,float b,float c){float r;asm("v_max3_f32 %0, %1, %2, %3":"=v"(r):"v"(a),"v"(b),"v"(c));return r;}
__device__ __forceinline__ float max2f(float a,float b){float r;asm("v_max_f32_e32 %0, %1, %2":"=v"(r):"v"(a),"v"(b));return r;}
__device__ __forceinline__ float fadd_s(float a,float b){float r;asm("v_add_f32_e32 %0, %1, %2":"=v"(r):"v"(a),"v"(b));return r;}
__device__ __forceinline__ float fsub_s(float a,float b){float r;asm("v_sub_f32_e32 %0, %1, %2":"=v"(r):"v"(a),"v"(b));return r;}
typedef float f32x2_t __attribute__((ext_vector_type(2))); typedef __bf16 bf16x2_t __attribute__((ext_vector_type(2)));
__device__ __forceinline__ unsigned cvtpk_s(float lo,float hi){f32x2_t v={lo,hi};bf16x2_t b=__builtin_convertvector(v,bf16x2_t);return __builtin_bit_cast(unsigned,b);}
#define WAIT_BAR(N) asm volatile("s_waitcnt vmcnt(" #N ") lgkmcnt(0)\n\ts_barrier":::"memory")

__device__ __forceinline__ void qkt(f32x16&p0,f32x16&p1,const char*Kslot,const bf16x8*qr,int r32,int hi){
  const char*kb=Kslot+hi*1024+r32*16;
  #pragma unroll
  for(int d0=0;d0<4;++d0){
    const bf16x8 b0=*reinterpret_cast<const bf16x8*>(kb+d0*2048);
    const bf16x8 b1=*reinterpret_cast<const bf16x8*>(kb+d0*2048+512);
    p0=__builtin_amdgcn_mfma_f32_32x32x16_bf16(b0,qr[d0],p0,0,0,0);p1=__builtin_amdgcn_mfma_f32_32x32x16_bf16(b1,qr[d0],p1,0,0,0);}
}
typedef __attribute__((address_space(3))) const char* lds_cptr;
typedef short v4i16_t __attribute__((ext_vector_type(4)));
__device__ __forceinline__ void kload8(bf16x8*kf,lds_cptr kp){
  kf[0]=*(const __attribute__((address_space(3))) bf16x8*)(kp);      kf[1]=*(const __attribute__((address_space(3))) bf16x8*)(kp+512);
  kf[2]=*(const __attribute__((address_space(3))) bf16x8*)(kp+2048); kf[3]=*(const __attribute__((address_space(3))) bf16x8*)(kp+2560);
  kf[4]=*(const __attribute__((address_space(3))) bf16x8*)(kp+4096); kf[5]=*(const __attribute__((address_space(3))) bf16x8*)(kp+4608);
  kf[6]=*(const __attribute__((address_space(3))) bf16x8*)(kp+6144); kf[7]=*(const __attribute__((address_space(3))) bf16x8*)(kp+6656);
}
__device__ __forceinline__ void kload2(bf16x8*kf,lds_cptr kp,int j){ kf[2*j]=*(const __attribute__((address_space(3))) bf16x8*)(kp+j*2048); kf[2*j+1]=*(const __attribute__((address_space(3))) bf16x8*)(kp+j*2048+512); }
__device__ __forceinline__ s16x4 vtr(lds_cptr p){ return __builtin_bit_cast(s16x4,__builtin_amdgcn_ds_read_tr16_b64_v4i16((__attribute__((address_space(3))) v4i16_t*)p)); }
__device__ __forceinline__ float rowmax(const f32x16&p0,const f32x16&p1){
  float a=max3f(p0[0],p0[1],p1[0]),b=max3f(p0[2],p0[3],p1[1]);a=max3f(a,p1[2],p1[3]);
  #pragma unroll
  for(int r=4;r<16;r+=4){a=max3f(a,p0[r],p0[r+1]);b=max3f(b,p0[r+2],p0[r+3]);a=max3f(a,p1[r],p1[r+1]);b=max3f(b,p1[r+2],p1[r+3]);}
  const float m=max2f(a,b);
  auto rr=__builtin_amdgcn_permlane32_swap(__float_as_uint(m),__float_as_uint(m),false,false);
  return max2f(__uint_as_float(rr[0]),__uint_as_float(rr[1]));
}
__device__ __forceinline__ void pv(f32x16*o,int vb,bf16x8 pa0,bf16x8 pa1,bf16x8 pa2,bf16x8 pa3){
  #pragma unroll
  for(int d0=0;d0<2;++d0){s16x4 lo[4],hi[4];
    #pragma unroll
    for(int ks=0;ks<4;++ks){
      asm volatile("ds_read_b64_tr_b16 %0,%1 offset:%c2":"=&v"(lo[ks]):"v"(vb),"i"(d0*4096+ks*1024):"memory");
      asm volatile("ds_read_b64_tr_b16 %0,%1 offset:%c2":"=&v"(hi[ks]):"v"(vb),"i"(d0*4096+ks*1024+512):"memory");}
    asm volatile("s_waitcnt lgkmcnt(0)":::"memory");SBAR();
    #define PK(k) (bf16x8){lo[k][0],lo[k][1],lo[k][2],lo[k][3],hi[k][0],hi[k][1],hi[k][2],hi[k][3]}
    o[d0]=__builtin_amdgcn_mfma_f32_32x32x16_bf16(pa0,PK(0),o[d0],0,0,0);
    o[d0]=__builtin_amdgcn_mfma_f32_32x32x16_bf16(pa1,PK(1),o[d0],0,0,0);
    o[d0]=__builtin_amdgcn_mfma_f32_32x32x16_bf16(pa2,PK(2),o[d0],0,0,0);
    o[d0]=__builtin_amdgcn_mfma_f32_32x32x16_bf16(pa3,PK(3),o[d0],0,0,0);
    #undef PK
  }
}

#ifndef ATTN_STORE16
#define ATTN_STORE16(p,v) (*(u32x4*)(p)=(v))
#endif
template<int MODE,int THRL> __device__ __forceinline__ void attn_unit(int qb,const bf16*Qh,const bf16*__restrict__ Kh,const bf16*__restrict__ Vh,bf16*Oh,const float*__restrict__ biasg,const float*__restrict__ knt,float slope2,float sink2,char*shm){
  const int tid=threadIdx.x,lane=tid&63,r32=lane&31,hi=lane>>5; const int wid=__builtin_amdgcn_readfirstlane(tid>>6);
  const int q0=qb*QB;
  const bf16*Qw=Qh+(long)(q0+wid*QBLK)*PP;
  const lds_cptr shm3=(lds_cptr)shm; const int qrel=wid*QBLK+r32;
  bf16x8 qr[4];
  #pragma unroll
  for(int d0=0;d0<4;++d0)qr[d0]=*reinterpret_cast<const bf16x8*>(&Qw[(long)r32*PP+d0*16+hi*8]);
  int T0=(MODE==1)?(qb?4*qb-2:0):0;
  int NT=(MODE==1)?(qb?6:4):(q0+QB)/KVBLK;
  float ref=0.f;
  if(MODE==0){
    ref=biasg[q0];
    const int NTF=NT; const bf16*Kq=Kh+(long)(q0+qrel)*PP; float qn2=0.f,dot=0.f;
    #pragma unroll
    for(int d0=0;d0<4;++d0){ const bf16x8 kq=*reinterpret_cast<const bf16x8*>(&Kq[d0*16+hi*8]);
      #pragma unroll
      for(int e=0;e<8;++e){ const float qf=__builtin_bit_cast(float,(unsigned)(unsigned short)qr[d0][e]<<16), kf_=__builtin_bit_cast(float,(unsigned)(unsigned short)kq[e]<<16); qn2+=qf*qf; dot+=qf*kf_; } }
    { auto rr=__builtin_amdgcn_permlane32_swap(__float_as_uint(qn2),__float_as_uint(qn2),false,false); qn2=__uint_as_float(rr[0])+__uint_as_float(rr[1]); }
    { auto rr=__builtin_amdgcn_permlane32_swap(__float_as_uint(dot),__float_as_uint(dot),false,false); dot=__uint_as_float(rr[0])+__uint_as_float(rr[1]); }
    float qn=sqrtf(qn2), lb=dot+(biasg[q0+qrel]-ref);
    #pragma unroll
    for(int o_=1;o_<32;o_<<=1){ qn=fmaxf(qn,__shfl_xor(qn,o_)); lb=fminf(lb,__shfl_xor(lb,o_)); }
    __attribute__((address_space(3))) float*red=(__attribute__((address_space(3))) float*)(shm3+LDS_MISC); __attribute__((address_space(3))) int*redi=(__attribute__((address_space(3))) int*)(shm3+LDS_MISC);
    if(lane==0){ red[wid]=qn; red[8+wid]=lb; } if(tid==0)redi[16]=NTF-4;
    asm volatile("s_waitcnt lgkmcnt(0)\n\ts_barrier":::"memory");
    float QN=red[0],LB=red[8];
    #pragma unroll
    for(int w_=1;w_<NW;++w_){ QN=fmaxf(QN,red[w_]); LB=fminf(LB,red[8+w_]); }
    if(tid<NTF-4){ const float ub=QN*1.01f*knt[tid]+(biasg[KVBLK*tid+KVBLK-1]-ref); if(!(ub<LB-40.0f))__hip_atomic_fetch_min(&redi[16],tid,__ATOMIC_RELAXED,__HIP_MEMORY_SCOPE_WORKGROUP); }
    asm volatile("s_waitcnt lgkmcnt(0)\n\ts_barrier":::"memory");
    T0=__builtin_amdgcn_readfirstlane(redi[16])&~1; NT=NTF-T0;
  }
  const unsigned lds0=(unsigned)(uintptr_t)shm;
  float*wsf=(float*)(shm+LDS_WS)+wid*64;
  const bf16*ksrc=Kh+(long)(T0*KVBLK+lane)*PP+wid*8;
  const bf16*vsrc=Vh+(long)(T0*KVBLK+16*(wid&3)+(lane>>2))*PP+(wid>>2)*32+(lane&3)*8;
  const unsigned kdst=lds0+LDS_K+wid*1024, vdst=lds0+LDS_V+wid*1024;
  #define DMA_K(t,slot) glds16(ksrc+(long)(t)*KVBLK*PP,(unsigned)__builtin_amdgcn_readfirstlane(kdst+(slot)))
  #define DMA_V(t,slot) glds16(vsrc+(long)(t)*KVBLK*PP,(unsigned)__builtin_amdgcn_readfirstlane(vdst+(slot)))
  const int vb0=(int)(lds0+LDS_V)+((lane>>4)&1)*32+(lane&3)*8+(4*hi+((lane&15)>>2))*64;
  const char*Kbase=shm+LDS_K; bf16x8 kf[8];
  const lds_cptr kp0=shm3+LDS_K+hi*1024+r32*16; const lds_cptr vp0=shm3+LDS_V+((lane>>4)&1)*32+(lane&3)*8+(4*hi+((lane&15)>>2))*64;
  DMA_K(0,0);DMA_V(0,0);DMA_K(1,SLOTB);
  float mhat=0.f,l_reg=0.f;f32x16 o[2];o[0]=f32x16{};o[1]=f32x16{};
  { __attribute__((address_space(3))) float*Tb=(__attribute__((address_space(3))) float*)(shm3+LDS_BIAS);
    if(MODE==0){ for(int k=tid;k<NT*KVBLK;k+=NW*64)Tb[k]=biasg[T0*KVBLK+k]-ref; }
    else{ const int koff=T0*KVBLK-q0; for(int k=tid;k<NT*KVBLK;k+=NW*64)Tb[k]=slope2*(float)(k+koff); } }
  const __attribute__((address_space(3))) f32x4v*Tl=(const __attribute__((address_space(3))) f32x4v*)(shm3+LDS_BIAS)+hi;
  const float sinkc=sink2+slope2*(float)qrel;
  #define CMASK(P0,P1,t) do{ if(MODE==1){ swamask(P0,P1,(T0+(t))*KVBLK-q0,qrel,hi); } else { int jb_=(t)-(NT-4); if(jb_>=0)cmask(P0,P1,jb_,qrel,hi); } }while(0)
  bool resc=false;
  #define START(P0,P1) do{ float rm=rowmax(P0,P1); if(MODE==1)rm=max2f(rm,sinkc); resc=false; \
    { const float dl=rm; mhat=fadd_s(mhat,dl); \
      _Pragma("unroll") for(int r=0;r<16;++r){P0[r]=fsub_s(P0[r],dl);P1[r]=fsub_s(P1[r],dl);} } \
    _Pragma("unroll") for(int r=0;r<16;++r)P0[r]=__builtin_amdgcn_exp2f(P0[r]); }while(0)
  #define RESC() do{ if(resc){ asm volatile("s_waitcnt lgkmcnt(0)":::"memory"); \
      _Pragma("unroll") for(int d_=0;d_<2;++d_) _Pragma("unroll") for(int r=0;r<16;++r)o[d_][r]*=wsf[crow(r,hi)]; } }while(0)
  #define BL0(X0,t,g_) do{ const f32x4v a_=Tl[(t)*16+2*(g_)]; X0[4*(g_)]=a_[0];X0[4*(g_)+1]=a_[1];X0[4*(g_)+2]=a_[2];X0[4*(g_)+3]=a_[3]; }while(0)
  #define BL1(X1,t,g_) do{ const f32x4v b_=Tl[(t)*16+8+2*(g_)]; X1[4*(g_)]=b_[0];X1[4*(g_)+1]=b_[1];X1[4*(g_)+2]=b_[2];X1[4*(g_)+3]=b_[3]; }while(0)
  #define BLALL(X0,X1,t) do{ BL0(X0,t,0);BL0(X0,t,1);BL0(X0,t,2);BL0(X0,t,3);BL1(X1,t,0);BL1(X1,t,1);BL1(X1,t,2);BL1(X1,t,3); }while(0)
  #define SUBM(X0,X1) do{ _Pragma("unroll") for(int r=0;r<16;++r){X0[r]-=mhat;X1[r]-=mhat;} }while(0)
  f32x16 pA0,pA1,pB0,pB1;
  int sl_prev=0,sl_cur=0,sl_next=SLOTB;
  #define ROT() do{sl_prev=sl_cur;sl_cur=sl_next;sl_next=(sl_next==(NSLOT-1)*SLOTB)?0:sl_next+SLOTB;}while(0)
  DMA_K(2,2*SLOTB);
  WAIT_BAR(3);
  BLALL(pA0,pA1,0);
  qkt(pA0,pA1,Kbase,qr,r32,hi);asm volatile("s_nop 15\n\ts_nop 7":"+v"(pA0),"+v"(pA1));CMASK(pA0,pA1,0);
  START(pA0,pA1);
  _Pragma("unroll") for(int r=0;r<16;++r)pA1[r]=__builtin_amdgcn_exp2f(pA1[r]);
  BLALL(pB0,pB1,1);
  WAIT_BAR(0);
  DMA_K(3,0);DMA_V(1,SLOTB);
  ROT();
  kload8(kf,kp0+sl_cur);
  WAIT_BAR(2);
  s16x4 vlo[8],vhi[8]; u32x4 pw0,pw1,pw2,pw3;
  #define PKW(P,B) cvtpk_s(P[B],P[B+1])
  #define PAF(k) __builtin_bit_cast(bf16x8,pw##k)
  #define VFR(i) (bf16x8){vlo[i][0],vlo[i][1],vlo[i][2],vlo[i][3],vhi[i][0],vhi[i][1],vhi[i][2],vhi[i][3]}
  #define PIN(x) asm volatile("":"+v"(x))
  #define MX3(a,b,c) __builtin_fmaxf(__builtin_fmaxf((a),(b)),(c))
  #define GAPA(MF,A0,A1,A2,A3,W0,W1,PW) do{ MF; sacc+=A0; sacc+=A1; sacc+=A2; sacc+=A3; PIN(sacc); W0; W1; PIN(PW); SBAR(); }while(0)
  #define EX(v) __builtin_amdgcn_exp2f(v)
  #define GAPB(MF,X,B) do{ MF; X[B]=EX(X[B]); X[B+1]=EX(X[B+1]); X[B+2]=EX(X[B+2]); X[B+3]=EX(X[B+3]); PIN(X); SBAR(); }while(0)
  #define VRD(i) do{ vlo[i]=vtr(vp_+(((i)>>2)*4096+((i)&3)*1024)); vhi[i]=vtr(vp_+(((i)>>2)*4096+((i)&3)*1024+512)); }while(0)
  #define KRD(G,j) do{ if(G){ kload2(kf,kp0+sl_next,j); SBAR(); } }while(0)
  #define BLD(G,LD) do{ if(G){ LD; SBAR(); } }while(0)
  #define STEP(C0,C1,P0,P1,t,GK,GV,GL) do{ SBAR(); SUBM(C0,C1); SBAR(); \
    const lds_cptr vp_=vp0+sl_prev; \
    VRD(0); SBAR(); float sacc=(P0[0]+P0[1]); \
    GAPA(C0=__builtin_amdgcn_mfma_f32_32x32x16_bf16(kf[0],qr[0],C0,0,0,0), P0[2],P0[3],P0[4],P0[5],     pw0[0]=PKW(P0,0), pw0[1]=PKW(P0,2), pw0); \
    VRD(4); SBAR(); GAPA(C1=__builtin_amdgcn_mfma_f32_32x32x16_bf16(kf[1],qr[0],C1,0,0,0), P0[6],P0[7],P0[8],P0[9],     pw0[2]=PKW(P0,4), pw0[3]=PKW(P0,6), pw0); \
    VRD(1); SBAR(); GAPA(C0=__builtin_amdgcn_mfma_f32_32x32x16_bf16(kf[2],qr[1],C0,0,0,0),   P0[10],P0[11],P0[12],P0[13], pw1[0]=PKW(P0,8), pw1[1]=PKW(P0,10), pw1); \
    VRD(5); SBAR(); GAPA(C1=__builtin_amdgcn_mfma_f32_32x32x16_bf16(kf[3],qr[1],C1,0,0,0),   P0[14],P0[15],P1[0],P1[1],   pw1[2]=PKW(P0,12),pw1[3]=PKW(P0,14), pw1); \
    VRD(2); SBAR(); GAPA(C0=__builtin_amdgcn_mfma_f32_32x32x16_bf16(kf[4],qr[2],C0,0,0,0),   P1[2],P1[3],P1[4],P1[5],     pw2[0]=PKW(P1,0), pw2[1]=PKW(P1,2), pw2); \
    VRD(6); SBAR(); GAPA(C1=__builtin_amdgcn_mfma_f32_32x32x16_bf16(kf[5],qr[2],C1,0,0,0),   P1[6],P1[7],P1[8],P1[9],     pw2[2]=PKW(P1,4), pw2[3]=PKW(P1,6), pw2); \
    VRD(3); SBAR(); GAPA(C0=__builtin_amdgcn_mfma_f32_32x32x16_bf16(kf[6],qr[3],C0,0,0,0),   P1[10],P1[11],P1[12],P1[13], pw3[0]=PKW(P1,8), pw3[1]=PKW(P1,10), pw3); \
    VRD(7); SBAR(); GAPA(C1=__builtin_amdgcn_mfma_f32_32x32x16_bf16(kf[7],qr[3],C1,0,0,0),   P1[14],P1[15],0.f,0.f,       pw3[2]=PKW(P1,12),pw3[3]=PKW(P1,14), pw3); \
    l_reg+=sacc; \
    if(GK){DMA_K((t)+3,sl_cur);} if(GV){DMA_V((t)+1,sl_next);} \
    CMASK(C0,C1,t); \
    { float a=MX3(C0[0],C0[1],C1[0]),b=MX3(C0[2],C0[3],C1[1]); a=MX3(a,C1[2],C1[3]); \
      _Pragma("unroll") for(int r=4;r<16;r+=4){a=MX3(a,C0[r],C0[r+1]);b=MX3(b,C0[r+2],C0[r+3]);a=MX3(a,C1[r],C1[r+1]);b=MX3(b,C1[r+2],C1[r+3]);} \
      float rm=__builtin_fmaxf(a,b); { auto rr=__builtin_amdgcn_permlane32_swap(__float_as_uint(rm),__float_as_uint(rm),false,false); rm=__builtin_fmaxf(__uint_as_float(rr[0]),__uint_as_float(rr[1])); } \
      resc=false; \
      if(__builtin_expect(__any(rm>(float)THRL),0)){ const float dl=__builtin_fmaxf(rm,0.f); mhat+=dl; \
        _Pragma("unroll") for(int r=0;r<16;++r){C0[r]-=dl;C1[r]-=dl;} \
        const float f=__builtin_amdgcn_exp2f(-dl); l_reg*=f; if(hi==0)wsf[r32]=f; resc=true; } } \
    SBAR(); \
    BLD(GL,BL0(P0,(t)+1,0);BL0(P0,(t)+1,1)); GAPB(o[0]=__builtin_amdgcn_mfma_f32_32x32x16_bf16(PAF(0),VFR(0),o[0],0,0,0), C0,0); \
    BLD(GL,BL0(P0,(t)+1,2);BL0(P0,(t)+1,3)); GAPB(o[1]=__builtin_amdgcn_mfma_f32_32x32x16_bf16(PAF(0),VFR(4),o[1],0,0,0), C0,4); \
    KRD(GL,0); GAPB(o[0]=__builtin_amdgcn_mfma_f32_32x32x16_bf16(PAF(1),VFR(1),o[0],0,0,0), C0,8); \
    KRD(GL,1); GAPB(o[1]=__builtin_amdgcn_mfma_f32_32x32x16_bf16(PAF(1),VFR(5),o[1],0,0,0), C0,12); \
    KRD(GL,2); GAPB(o[0]=__builtin_amdgcn_mfma_f32_32x32x16_bf16(PAF(2),VFR(2),o[0],0,0,0), C1,0); \
    KRD(GL,3); GAPB(o[1]=__builtin_amdgcn_mfma_f32_32x32x16_bf16(PAF(2),VFR(6),o[1],0,0,0), C1,4); \
    BLD(GL,BL1(P1,(t)+1,0);BL1(P1,(t)+1,1)); GAPB(o[0]=__builtin_amdgcn_mfma_f32_32x32x16_bf16(PAF(3),VFR(3),o[0],0,0,0), C1,8); \
    BLD(GL,BL1(P1,(t)+1,2);BL1(P1,(t)+1,3)); GAPB(o[1]=__builtin_amdgcn_mfma_f32_32x32x16_bf16(PAF(3),VFR(7),o[1],0,0,0), C1,12); \
    }while(0)
  int t=1;
  #undef CMASK
  #define CMASK(P0,P1,t) do{}while(0)
  for(;t+5<NT;t+=2){
    STEP(pB0,pB1,pA0,pA1,t,true,true,true);     WAIT_BAR(2); RESC(); ROT();
    STEP(pA0,pA1,pB0,pB1,t+1,true,true,true);   WAIT_BAR(2); RESC(); ROT();
  }
  #undef CMASK
  #define CMASK(P0,P1,t) do{ if(MODE==1){ swamask(P0,P1,(T0+(t))*KVBLK-q0,qrel,hi); } else { int jb_=(t)-(NT-4); if(jb_>=0)cmask(P0,P1,jb_,qrel,hi); } }while(0)
  #define ENDW(tt) do{ if((tt)+3<NT){WAIT_BAR(2);} else if((tt)+2<NT){WAIT_BAR(1);} else {WAIT_BAR(0);} }while(0)
  for(;t+1<NT;t+=2){
    STEP(pB0,pB1,pA0,pA1,t,(t+3<NT),(t+1<NT),(t+1<NT));       ENDW(t);   RESC(); ROT();
    STEP(pA0,pA1,pB0,pB1,t+1,(t+4<NT),(t+2<NT),(t+2<NT));     ENDW(t+1); RESC(); ROT();
  }
  STEP(pB0,pB1,pA0,pA1,NT-1,false,false,false); RESC();
  { float sacc=pB0[0]+pB0[1]; _Pragma("unroll") for(int r=2;r<16;++r)sacc+=pB0[r]; _Pragma("unroll") for(int r=0;r<16;++r)sacc+=pB1[r]; l_reg+=sacc;
    pw0=(u32x4){PKW(pB0,0),PKW(pB0,2),PKW(pB0,4),PKW(pB0,6)};pw1=(u32x4){PKW(pB0,8),PKW(pB0,10),PKW(pB0,12),PKW(pB0,14)};pw2=(u32x4){PKW(pB1,0),PKW(pB1,2),PKW(pB1,4),PKW(pB1,6)};pw3=(u32x4){PKW(pB1,8),PKW(pB1,10),PKW(pB1,12),PKW(pB1,14)};
    SBAR(); pv(o,vb0+sl_cur,PAF(0),PAF(1),PAF(2),PAF(3)); }
  #undef PKW
  #undef PAF
  #undef VFR
  #undef PIN
  #undef MX3
  #undef GAPA
  #undef GAPB
  #undef EX
  #undef VRD
  #undef KRD
  #undef BLD
  #undef STEP
  #undef ENDW
  {auto rr=__builtin_amdgcn_permlane32_swap(__float_as_uint(l_reg),__float_as_uint(l_reg),false,false);l_reg=__uint_as_float(rr[0])+__uint_as_float(rr[1]);}
  if(MODE==1)l_reg+=__builtin_amdgcn_exp2f(sinkc-mhat);
  if(hi==0)wsf[32+r32]=l_reg;asm volatile("s_waitcnt lgkmcnt(0)":::"memory");
  float rli[16];
  #pragma unroll
  for(int r=0;r<16;++r)rli[r]=__builtin_amdgcn_rcpf(wsf[32+crow(r,hi)]);
  bf16*Ow=Oh+(long)(q0+wid*QBLK)*OP;
  { bf16*stg=(bf16*)(shm+LDS_OST)+wid*2048;
    #pragma unroll
    for(int r=0;r<16;++r){const int orow=crow(r,hi);
      #pragma unroll
      for(int d0=0;d0<2;++d0)stg[orow*64+d0*32+r32]=__float2bfloat16(o[d0][r]*rli[r]);}
    asm volatile("s_waitcnt lgkmcnt(0)":::"memory");
    #pragma unroll
    for(int i=0;i<4;++i){const int row=i*8+(lane>>3),ch=lane&7; const u32x4 v=*(const u32x4*)(stg+row*64+ch*8); ATTN_STORE16(Ow+(long)row*OP+ch*8,v);} }
  asm volatile("s_waitcnt lgkmcnt(0)\n\ts_barrier":::"memory");
  #undef DMA_K
  #undef DMA_V
  #undef CMASK
  #undef BL0
  #undef BL1
  #undef BLALL
  #undef SUBM
  #undef START
  #undef RESC
  #undef ROT
}
constexpr int ATTN_LDS_BYTES=LDS_BYTES;
struct AttnArgs { const bf16* proj; bf16* obuf; const float* bias; const float* knt; const float* sinks; unsigned* queue; };
template<int THRL=8> __device__ __forceinline__ void attn_phase(char*lds,const AttnArgs&T,int vcu,int G){
  for(int j=vcu;j<1024;j+=G){
    const int v=j&255,i=j>>8,bh=v>>3,s=v&7,b=bh>>4,h=bh&15; const long rb=(long)b*SEQ; const int qb=4*s+i;
    const float slope2=exp2f(-0.5f*(float)(h+1))*1.4426950408889634f, sink2=T.sinks[h]*1.4426950408889634f;
    attn_unit<1,THRL>(qb,T.proj+rb*PP+h*D,T.proj+rb*PP+1024+(h>>2)*D,T.proj+rb*PP+1280+(h>>2)*D,T.obuf+rb*OP+h*D,nullptr,nullptr,slope2,sink2,lds);
  }
  __attribute__((address_space(3))) int*qw=(__attribute__((address_space(3))) int*)((lds_cptr)lds+LDS_MISC)+20;
  for(;;){
    if(threadIdx.x==0)*qw=(int)__hip_atomic_fetch_add(T.queue,1u,__ATOMIC_RELAXED,__HIP_MEMORY_SCOPE_AGENT);
    __syncthreads();
    const int j=__builtin_amdgcn_readfirstlane(*qw);
    if(j>=1024)break;
    const int qb=31-(j>>5),bh=j&31,b=bh>>4,h=bh&15; const long rb=(long)b*SEQ;
    attn_unit<0,THRL>(qb,T.proj+rb*PP+1536+h*D,T.proj+rb*PP+2560+h*D,T.proj+rb*PP+3584+h*D,T.obuf+rb*OP+1024+h*D,T.bias+(long)bh*SEQ,T.knt+bh*(SEQ/KVBLK),0.f,0.f,lds);
  }
}
#undef SBAR
#undef WAIT_BAR
}

constexpr int NWAVES = 8;
#ifndef MK_N_LAUNCHES
#define MK_N_LAUNCHES 1
#endif
constexpr int PER_PHASE = 13;
constexpr int N_LAUNCHES = MK_N_LAUNCHES;
constexpr int BATCH = 2, SEQ = 8192, DM = 2048, M = BATCH * SEQ;
constexpr int NPROJ = 4864, PROJ_P = 4608, NCOLS_IN = 4624;
constexpr int NEXP = 32, DEXP = 512, LIST_CAP = pg8::LIST_CAP;
constexpr float EPS = 1e-6f;
constexpr size_t MiB = 1u << 20;
constexpr size_t WS_CTL = 0, CTL_ZERO_BYTES = 1 * MiB;
constexpr size_t WS_MOD = 1 * MiB;
constexpr size_t WS_LOGF = 2 * MiB;
constexpr size_t WS_BIAS = 3 * MiB;
constexpr size_t WS_LOGITS = 4 * MiB;
constexpr size_t WS_SLOT = 8 * MiB;
constexpr size_t WS_EW = 8 * MiB + 512 * 1024;
constexpr size_t WS_KNT = 8 * MiB + 768 * 1024;
constexpr size_t WS_LIST = 9 * MiB;
constexpr size_t WS_WR = 12 * MiB;
constexpr size_t WS_WIN = 13 * MiB;
constexpr size_t WS_WOUT = 32 * MiB;
constexpr size_t WS_WGU = 40 * MiB;
constexpr size_t WS_WDN = 168 * MiB;
constexpr size_t WS_XN = 232 * MiB;
constexpr size_t WS_PROJ = 296 * MiB;
constexpr size_t WS_OBUF = 440 * MiB;
constexpr size_t WS_HID = 504 * MiB;
constexpr size_t WS_YS = WS_PROJ;
constexpr size_t WS_END = 544 * MiB;
static_assert(WS_YS + (size_t)40960 * 2048 * 2 <= WS_HID && WS_HID + (size_t)40960 * 512 * 2 <= WS_END, "d_ws map");
constexpr int CW_TMO = 0, CW_CODE = 1, CW_BAR = 4096, CW_CNT = 8192, CW_QUEUE = 8320;
constexpr int RING_OFF = 0, RING_BYTES = 131072;
constexpr int LDSCTL_OFF = RING_BYTES, MISC_OFF = LDSCTL_OFF + 320;
constexpr int LDS_BYTES = 147456;
static_assert(attn_body::ATTN_LDS_BYTES <= RING_BYTES && pg8::STAGE_BYTES <= RING_BYTES, "phase scratch fits the ring region");
#define GAS __attribute__((address_space(1)))
#define LAS __attribute__((address_space(3)))
typedef unsigned short bf16;
typedef unsigned v4u __attribute__((ext_vector_type(4)));
typedef float f32x4 __attribute__((ext_vector_type(4)));
typedef short bf16x8 __attribute__((ext_vector_type(8)));
typedef GAS unsigned gu32;
typedef GAS unsigned long long gu64;
#define RLX_AGENT __ATOMIC_RELAXED, __HIP_MEMORY_SCOPE_AGENT
#define LDS_WAIT() asm volatile("s_waitcnt lgkmcnt(0)" ::: "memory")
#define VM_WAIT() asm volatile("s_waitcnt vmcnt(0)" ::: "memory")
__device__ __forceinline__ unsigned long long rt() { return __builtin_amdgcn_s_memrealtime(); }
__device__ __forceinline__ unsigned f2bf(float f) { unsigned u = __builtin_bit_cast(unsigned, f); return (u + 0x7fffu + ((u >> 16) & 1u)) >> 16; }
__device__ __forceinline__ unsigned pk2(float lo, float hi) { return f2bf(lo) | (f2bf(hi) << 16); }

#define XB_TMO      128
#define XB_XCNT(j)  (256  + 64 * (j))
#define XB_XSUB(j)  (1280 + 64 * (j))
#define XB_XGEN(j)  (2304 + 64 * (j))
#define XB_TOP      3328
#define XB_TOPGEN   3392
#define XCD_BAR_WORDS 3456
#define XB_SPIN_CAP (1u << 18)

__device__ __forceinline__ unsigned xb_ld(unsigned* p)              { return __hip_atomic_load(p, __ATOMIC_RELAXED, __HIP_MEMORY_SCOPE_AGENT); }
__device__ __forceinline__ unsigned xb_add(unsigned* p, unsigned v) { return __hip_atomic_fetch_add(p, v, __ATOMIC_RELAXED, __HIP_MEMORY_SCOPE_AGENT); }
__device__ __forceinline__ unsigned xb_xcc_id() { return (unsigned)__builtin_amdgcn_s_getreg((3 << 11) | 20) & 0xFu; }
#define XB_SPIN(cond, bar) do { unsigned _sp = 0; while (cond) { __builtin_amdgcn_s_sleep(1); \
    if ((++_sp & 255u) == 0u) { if (xb_ld(&(bar)[XB_TMO])) break; if (_sp > XB_SPIN_CAP) { atomicAdd(&(bar)[XB_TMO], 1u); break; } } } } while (0)

struct XcdBarrier {
    unsigned* bar; unsigned x;
    volatile LAS unsigned* st;
};

__device__ __forceinline__ XcdBarrier xcd_barrier_post(unsigned* bar, volatile LAS unsigned* st) {
    XcdBarrier b; b.bar = bar; b.x = xb_xcc_id(); b.st = st;
    if (threadIdx.x == 0) (void)xb_add(&bar[XB_XCNT(b.x)], 1u);
    return b;
}
__device__ __forceinline__ void xcd_barrier_complete(unsigned* bar, unsigned x, unsigned& nloc, unsigned& nx) {
    const unsigned G = gridDim.x * gridDim.y * gridDim.z;
    unsigned sum, cnt, mine, sp = 0u;
    for (;;) {
        sum = 0u; cnt = 0u; mine = 0u;
#pragma unroll
        for (unsigned j = 0; j < 16; ++j) { const unsigned c = xb_ld(&bar[XB_XCNT(j)]); sum += c; cnt += (c > 0u) ? 1u : 0u; mine = (j == x) ? c : mine; }
        if (sum == G) break;
        __builtin_amdgcn_s_sleep(1);
        if ((++sp & 255u) == 0u) { if (xb_ld(&bar[XB_TMO])) break; if (sp > XB_SPIN_CAP) { atomicAdd(&bar[XB_TMO], 1u); break; } }
    }
    nloc = mine > 0u ? mine : 1u; nx = cnt > 0u ? cnt : 1u;
}

__device__ __forceinline__ void xcd_barrier(const XcdBarrier& b) {
    asm volatile("s_waitcnt vmcnt(0)" ::: "memory");
    __syncthreads();
    if (threadIdx.x == 0) {
        unsigned* bar = b.bar;
        __builtin_amdgcn_s_waitcnt(0);
        unsigned nloc = b.st[0], nx = b.st[1];
        if (nloc == 0u) { xcd_barrier_complete(bar, b.x, nloc, nx); b.st[0] = nloc; b.st[1] = nx; }
        const unsigned old = xb_add(&bar[XB_XSUB(b.x)], 1u);
        const unsigned gen = old / nloc;
        if (old + 1u == (gen + 1u) * nloc) {
            __builtin_amdgcn_fence(__ATOMIC_RELEASE, "agent");
            asm volatile("s_waitcnt vmcnt(0)" ::: "memory");
            const unsigned og = xb_add(&bar[XB_TOP], 1u);
            const unsigned tg = og / nx;
            if (og + 1u == (tg + 1u) * nx) xb_add(&bar[XB_TOPGEN], 1u);
            else XB_SPIN(xb_ld(&bar[XB_TOPGEN]) == tg, bar);
            __builtin_amdgcn_fence(__ATOMIC_ACQUIRE, "agent");
            xb_add(&bar[XB_XGEN(b.x)], 1u);
            asm volatile("s_waitcnt vmcnt(0)" ::: "memory");
        } else {
            XB_SPIN(xb_ld(&bar[XB_XGEN(b.x)]) == gen, bar);
            __builtin_amdgcn_fence(__ATOMIC_ACQUIRE, "agent");
            asm volatile("s_waitcnt vmcnt(0)" ::: "memory");
        }
    }
    __syncthreads();
}

__device__ __forceinline__ float wave_sum(float v) {
#pragma unroll
    for (int o = 1; o < 64; o <<= 1) v += __shfl_xor(v, o);
    return v;
}
__device__ __forceinline__ void p0_mod_item(LAS unsigned char* lds, const float* c, const float* w_ada, const float* b_ada, float* mod, int item, int tid) {
    LAS float* sc = (LAS float*)lds; LAS float* red = (LAS float*)(lds + 16384);
    for (int i = tid; i < 2 * DM; i += NWAVES * 64) { const float v = c[i]; sc[i] = v / (1.0f + expf(-v)); }
    __syncthreads();
    const int cg = tid & 15, rg = tid >> 4, n0 = item * 64;
    f32x4 a0 = {0.f, 0.f, 0.f, 0.f}, a1 = {0.f, 0.f, 0.f, 0.f};
    const float* wp = w_ada + (size_t)rg * (6 * DM) + n0 + 4 * cg;
#pragma unroll 8
    for (int k = rg; k < DM; k += 32) { const f32x4 w = *(const f32x4*)wp; wp += (size_t)32 * (6 * DM); a0 += sc[k] * w; a1 += sc[DM + k] * w; }
    *(LAS f32x4*)(red + (rg * 2 + 0) * 64 + 4 * cg) = a0; *(LAS f32x4*)(red + (rg * 2 + 1) * 64 + 4 * cg) = a1;
    __syncthreads();
    if (tid < 128) { const int b = tid >> 6, col = tid & 63; float s = 0.f;
#pragma unroll 8
        for (int r = 0; r < 32; ++r) s += red[(r * 2 + b) * 64 + col];
        mod[b * (6 * DM) + n0 + col] = s + b_ada[n0 + col]; }
    __syncthreads();
}
__device__ __forceinline__ void tr_item(const float* W, int Nsrc, int k0, int n0, bf16* dst, int Kd, LAS float* scr, int lane) {
    const int n = n0 + (lane & 31);
#pragma unroll 8
    for (int i = 0; i < 32; ++i) { const int kk = 2 * i + (lane >> 5); float v = 0.f; if (n < Nsrc) v = W[(size_t)(k0 + kk) * Nsrc + n]; scr[kk * 33 + (lane & 31)] = v; }
    LDS_WAIT(); asm volatile("" ::: "memory");
    const int c = lane & 7;
#pragma unroll
    for (int j = 0; j < 4; ++j) { const int nn = (lane >> 3) + 8 * j; const LAS float* s = scr + (8 * c) * 33 + nn;
        v4u o; o.x = pk2(s[0 * 33], s[1 * 33]); o.y = pk2(s[2 * 33], s[3 * 33]); o.z = pk2(s[4 * 33], s[5 * 33]); o.w = pk2(s[6 * 33], s[7 * 33]);
        *(GAS v4u*)(dst + (size_t)nn * Kd + k0 + 8 * c) = o; }
    LDS_WAIT(); asm volatile("" ::: "memory");
}
__device__ __forceinline__ void norm_mod_rows(const float* X, const float* g, const float* mod, int ish, int isc, bf16* OUT, int gw, int NGW, int lane) {
    int curb = -1; f32x4 ca[8], cb[8];
    for (int m = gw; m < M; m += NGW) {
        const int b = m >= SEQ ? 1 : 0;
        if (b != curb) { curb = b;
#pragma unroll
            for (int j = 0; j < 8; ++j) { const int col = 4 * lane + 256 * j; const f32x4 gv = *(const f32x4*)(g + col), sv = *(const f32x4*)(mod + b * (6 * DM) + isc * DM + col);
                ca[j] = gv * (sv + 1.0f); cb[j] = *(const f32x4*)(mod + b * (6 * DM) + ish * DM + col); } }
        const GAS f32x4* xr = (const GAS f32x4*)(X + (size_t)m * DM) + lane;
        f32x4 v[8]; float s = 0.f;
#pragma unroll
        for (int j = 0; j < 8; ++j) { v[j] = xr[64 * j]; s += (v[j].x * v[j].x + v[j].y * v[j].y) + (v[j].z * v[j].z + v[j].w * v[j].w); }
        const float rstd = 1.0f / sqrtf(wave_sum(s) * (1.0f / DM) + EPS);
        GAS unsigned long long* o8 = (GAS unsigned long long*)(OUT + (size_t)m * DM) + lane;
#pragma unroll
        for (int j = 0; j < 8; ++j) { const f32x4 h = v[j] * rstd * ca[j] + cb[j]; o8[64 * j] = (unsigned long long)pk2(h.x, h.y) | ((unsigned long long)pk2(h.z, h.w) << 32); }
    }
}
__device__ __forceinline__ float bf_lo(unsigned w) { return __builtin_bit_cast(float, w << 16); }
__device__ __forceinline__ float bf_hi(unsigned w) { return __builtin_bit_cast(float, w & 0xffff0000u); }
__device__ __forceinline__ void onorm_rows(bf16* O, const float* ga, const float* gb, int gw, int NGW, int lane) {
    f32x4 gg[4][2];
#pragma unroll
    for (int j = 0; j < 4; ++j) { const float* gp = (j < 2 ? ga + 512 * j : gb + 512 * (j - 2)) + 8 * lane; gg[j][0] = *(const f32x4*)gp; gg[j][1] = *(const f32x4*)(gp + 4); }
    for (int m = gw; m < M; m += NGW) {
        GAS v4u* row = (GAS v4u*)(O + (size_t)m * DM) + lane; v4u w[4]; float ss[4];
#pragma unroll
        for (int j = 0; j < 4; ++j) { w[j] = row[64 * j]; float s = 0.f;
#pragma unroll
            for (int q = 0; q < 4; ++q) { const float a = bf_lo(w[j][q]), b = bf_hi(w[j][q]); s += a * a + b * b; } ss[j] = s; }
        const float ra = 1.0f / sqrtf(wave_sum(ss[0] + ss[1]) * (1.0f / 1024.0f) + EPS), rb = 1.0f / sqrtf(wave_sum(ss[2] + ss[3]) * (1.0f / 1024.0f) + EPS);
#pragma unroll
        for (int j = 0; j < 4; ++j) { const float r = j < 2 ? ra : rb; v4u o;
#pragma unroll
            for (int q = 0; q < 4; ++q) { const float g0 = gg[j][q >> 1][(q & 1) * 2], g1 = gg[j][q >> 1][(q & 1) * 2 + 1]; o[q] = pk2(bf_lo(w[j][q]) * r * g0, bf_hi(w[j][q]) * r * g1); }
            row[64 * j] = o; }
    }
}
__device__ __forceinline__ void scan_seq(LAS unsigned char* lds, const float* logf, float* bias, int bh, int tid) {
    LAS float* wt = (LAS float*)lds; const int b = bh >> 4, h = bh & 15, lane = tid & 63, w = tid >> 6;
    const float* src = logf + ((size_t)b * SEQ + 16 * tid) * 16 + h; float v[16]; float tot = 0.f;
#pragma unroll
    for (int i = 0; i < 16; ++i) { tot += src[i * 16]; v[i] = tot; }
    float inc = tot;
#pragma unroll
    for (int o = 1; o < 64; o <<= 1) { const float t = __shfl_up(inc, o); if (lane >= o) inc += t; }
    if (lane == 63) wt[w] = inc;
    __syncthreads();
    float base = 0.f;
#pragma unroll
    for (int q = 0; q < NWAVES; ++q) { const float t = wt[q]; if (q < w) base += t; }
    const float off = base + (inc - tot); float* dst = bias + (size_t)bh * SEQ + 16 * tid;
#pragma unroll
    for (int i = 0; i < 16; i += 4) { f32x4 o; o[0] = -1.4426950408889634f * (off + v[i]); o[1] = -1.4426950408889634f * (off + v[i + 1]); o[2] = -1.4426950408889634f * (off + v[i + 2]); o[3] = -1.4426950408889634f * (off + v[i + 3]); *(f32x4*)(dst + i) = o; }
    __syncthreads();
}
__device__ __forceinline__ void knt_tiles(const bf16* proj, float* knt, int gw, int NGW, int lane) {
    for (int it = gw; it < 32 * (SEQ / 64); it += NGW) {
        const int bh = it >> 7, t = it & 127, b = bh >> 4, h = bh & 15;
        const GAS v4u* kr = (const GAS v4u*)(proj + ((size_t)b * SEQ + 64 * t + lane) * PROJ_P + 2560 + h * 64); float s = 0.f;
#pragma unroll
        for (int j = 0; j < 8; ++j) { const v4u w = kr[j];
#pragma unroll
            for (int q = 0; q < 4; ++q) { const float a = bf_lo(w[q]), c = bf_hi(w[q]); s += a * a + c * c; } }
        float n = sqrtf(s);
#pragma unroll
        for (int o = 1; o < 64; o <<= 1) n = fmaxf(n, __shfl_xor(n, o));
        if (lane == 0) knt[it] = n;
    }
}
__device__ __forceinline__ void route_block(LAS unsigned char* lds, const float* logits, const float* b_group, const float* b_expert, gu32* gcnt, int* list, int* slot, float* ew, int tok0, int tid) {
    LAS int* lcnt = (LAS int*)lds; LAS int* gbase = lcnt + 32;
    if (tid < 32) lcnt[tid] = 0;
    __syncthreads();
    int e1 = 0, e2 = 0, p1 = 0, p2 = 0; float w1 = 0.f, w2 = 0.f; const int tok = tok0 + tid;
    if (tid < 64) {
        const float* lr = logits + (size_t)tok * 64;
        float gl[4]; int gs = 0; float gmax;
#pragma unroll
        for (int j = 0; j < 4; ++j) gl[j] = lr[j] + b_group[j];
        gmax = gl[0];
#pragma unroll
        for (int j = 1; j < 4; ++j) if (gl[j] > gmax) { gmax = gl[j]; gs = j; }
        float den = 0.f;
#pragma unroll
        for (int j = 0; j < 4; ++j) den += expf(gl[j] - gmax);
        const float gval = 1.0f / den;
        float el[8];
        { const f32x4 ea = *(const f32x4*)(lr + 4 + 8 * gs), eb = *(const f32x4*)(lr + 8 + 8 * gs), ba = *(const f32x4*)(b_expert + 8 * gs), bb = *(const f32x4*)(b_expert + 8 * gs + 4);
#pragma unroll
          for (int j = 0; j < 4; ++j) { el[j] = ea[j] + ba[j]; el[4 + j] = eb[j] + bb[j]; } }
        int i1 = 0; float v1 = el[0];
#pragma unroll
        for (int j = 1; j < 8; ++j) if (el[j] > v1) { v1 = el[j]; i1 = j; }
        int i2 = -1; float v2 = -INFINITY;
#pragma unroll
        for (int j = 0; j < 8; ++j) if (j != i1 && el[j] > v2) { v2 = el[j]; i2 = j; }
        const float t = expf(v2 - v1); w1 = gval / (1.0f + t); w2 = gval * t / (1.0f + t);
        e1 = 8 * gs + i1; e2 = 8 * gs + i2;
        p1 = __hip_atomic_fetch_add(&lcnt[e1], 1, __ATOMIC_RELAXED, __HIP_MEMORY_SCOPE_WORKGROUP); p2 = __hip_atomic_fetch_add(&lcnt[e2], 1, __ATOMIC_RELAXED, __HIP_MEMORY_SCOPE_WORKGROUP);
    }
    __syncthreads();
    if (tid < 32) { const int n = lcnt[tid]; gbase[tid] = n ? (int)__hip_atomic_fetch_add(gcnt + tid, (unsigned)n, RLX_AGENT) : 0; }
    __syncthreads();
    if (tid < 64) {
        p1 += gbase[e1]; p2 += gbase[e2];
        list[(size_t)e1 * LIST_CAP + p1] = tok; list[(size_t)e2 * LIST_CAP + p2] = tok;
        slot[2 * tok] = (e1 << 16) | p1; slot[2 * tok + 1] = (e2 << 16) | p2; ew[2 * tok] = w1; ew[2 * tok + 1] = w2;
    }
    __syncthreads();
}
__device__ __forceinline__ void moe_tables(LAS unsigned char* ldsctl, gu32* gcnt, int tid) {
    LAS int* pfx = (LAS int*)ldsctl; LAS int* cnt = (LAS int*)(ldsctl + 160);
    if (tid < 32) cnt[tid] = (int)__hip_atomic_load(gcnt + tid, RLX_AGENT);
    __syncthreads();
    if (tid == 0) { int a = 0; for (int e = 0; e < 32; ++e) { pfx[e] = a; a += (cnt[e] + 255) >> 8; } pfx[32] = a; }
    __syncthreads();
}
__device__ __forceinline__ void final_rows(float* out, const bf16* YS, const int* slot, const float* ew, const float* mod, const float* fg, const LAS int* pfx, int gw, int NGW, int lane) {
    int curb = -1; f32x4 gm[4][2], gf[4][2];
#pragma unroll
    for (int j = 0; j < 4; ++j) { gf[j][0] = *(const f32x4*)(fg + 8 * lane + 512 * j); gf[j][1] = *(const f32x4*)(fg + 8 * lane + 512 * j + 4); }
    for (int m = gw; m < M; m += NGW) {
        const int b = m >= SEQ ? 1 : 0;
        if (b != curb) { curb = b;
#pragma unroll
            for (int j = 0; j < 4; ++j) { const float* p = mod + b * (6 * DM) + 5 * DM + 8 * lane + 512 * j; gm[j][0] = *(const f32x4*)p; gm[j][1] = *(const f32x4*)(p + 4); } }
        const int s0 = slot[2 * m], s1 = slot[2 * m + 1]; const float w0 = ew[2 * m], w1 = ew[2 * m + 1];
        const size_t r0 = (size_t)(pfx[s0 >> 16] * 256 + (s0 & 0xffff)), r1 = (size_t)(pfx[s1 >> 16] * 256 + (s1 & 0xffff));
        const GAS v4u* y0 = (const GAS v4u*)(YS + r0 * DM) + lane; const GAS v4u* y1 = (const GAS v4u*)(YS + r1 * DM) + lane;
        GAS f32x4* xr = (GAS f32x4*)(out + (size_t)m * DM) + 2 * lane;
        f32x4 v[4][2]; float s = 0.f;
#pragma unroll
        for (int j = 0; j < 4; ++j) { const v4u a = y0[64 * j], c = y1[64 * j]; const f32x4 x0 = xr[128 * j], x1 = xr[128 * j + 1];
            f32x4 ya, yb; ya[0] = w0 * bf_lo(a[0]) + w1 * bf_lo(c[0]); ya[1] = w0 * bf_hi(a[0]) + w1 * bf_hi(c[0]); ya[2] = w0 * bf_lo(a[1]) + w1 * bf_lo(c[1]); ya[3] = w0 * bf_hi(a[1]) + w1 * bf_hi(c[1]);
            yb[0] = w0 * bf_lo(a[2]) + w1 * bf_lo(c[2]); yb[1] = w0 * bf_hi(a[2]) + w1 * bf_hi(c[2]); yb[2] = w0 * bf_lo(a[3]) + w1 * bf_lo(c[3]); yb[3] = w0 * bf_hi(a[3]) + w1 * bf_hi(c[3]);
            v[j][0] = x0 + gm[j][0] * ya; v[j][1] = x1 + gm[j][1] * yb;
#pragma unroll
            for (int q = 0; q < 2; ++q) s += (v[j][q].x * v[j][q].x + v[j][q].y * v[j][q].y) + (v[j][q].z * v[j][q].z + v[j][q].w * v[j][q].w); }
        const float rstd = 1.0f / sqrtf(wave_sum(s) * (1.0f / DM) + EPS);
#pragma unroll
        for (int j = 0; j < 4; ++j) { xr[128 * j] = v[j][0] * rstd * gf[j][0]; xr[128 * j + 1] = v[j][1] * rstd * gf[j][1]; }
    }
}

struct Args { const float* in[20]; float* out; unsigned char* ws; int ph_lo, ph_hi, li, pad; };
__global__ void __launch_bounds__(NWAVES * 64, 2) fwd_kernel(Args args) {
    extern __shared__ __attribute__((aligned(16))) unsigned char lds_raw[];
    LAS unsigned char* lds = (LAS unsigned char*)lds_raw;
    volatile LAS unsigned* MISC = (volatile LAS unsigned*)(lds + MISC_OFF);
    const int tid = threadIdx.x, lane = tid & 63, wave = __builtin_amdgcn_readfirstlane(tid >> 6);
    const int G = gridDim.x; const int bx = blockIdx.x; const int vcu = (G % 8 == 0) ? (bx % 8) * (G / 8) + bx / 8 : bx;
    const int gw = vcu * NWAVES + wave, NGW = G * NWAVES;
    typedef const __attribute__((address_space(4))) Args* kargp_t;
#define KP() ({ kargp_t kp_ = (kargp_t)__builtin_amdgcn_kernarg_segment_ptr(); asm volatile("" : "+s"(kp_)); kp_; })
#define WSP(kp, off) (kp->ws + (off))
    gu32* ctl = (gu32*)(args.ws + WS_CTL);
    for (int u = tid; u < (LDS_BYTES - LDSCTL_OFF) / 4; u += NWAVES * 64) ((LAS unsigned*)(lds + LDSCTL_OFF))[u] = 0u;
    __syncthreads();
    XcdBarrier bar; bar.bar = (unsigned*)(ctl + CW_BAR); bar.x = 0; bar.st = nullptr;
    if (N_LAUNCHES != PER_PHASE) bar = xcd_barrier_post((unsigned*)(ctl + CW_BAR), MISC + 8);
#define GRID_BAR(seam) do { if (N_LAUNCHES == PER_PHASE) { if (tid == 0) __hip_atomic_store(ctl + CW_TMO, 0xBADBA0u | (unsigned)(seam), RLX_AGENT); } else { xcd_barrier(bar); } } while (0)
    const int lo = args.ph_lo, hi = args.ph_hi;
#ifndef PH_MASK
#define PH_MASK 0x1fff
#endif
#define IN(k) ((((PH_MASK) >> (k)) & 1) && lo <= (k) && (k) < hi)
#define BOTH(k) (IN(k) && IN((k) + 1))

    if (IN(0)) {
        kargp_t kp = KP();
        const float *cvec = kp->in[1], *w_ada = kp->in[2], *b_ada = kp->in[3], *w_in = kp->in[5], *w_out = kp->in[10], *w_group = kp->in[12], *w_expert = kp->in[14], *w_gate = kp->in[16], *w_up = kp->in[17], *w_down = kp->in[18];
        unsigned char* ws = kp->ws; float* MOD = (float*)(ws + WS_MOD);
        bf16 *WR = (bf16*)(ws + WS_WR), *WIN = (bf16*)(ws + WS_WIN), *WOUT = (bf16*)(ws + WS_WOUT), *WGU = (bf16*)(ws + WS_WGU), *WDN = (bf16*)(ws + WS_WDN);
        for (int it = bx; it < (6 * DM) / 64; it += G) p0_mod_item(lds, cvec, w_ada, b_ada, MOD, it, tid);
        LAS float* scr = (LAS float*)(lds + RING_OFF + wave * 16384);
        constexpr int I_IN = 32 * 152, I_OUT = 32 * 64, I_G = 32 * 512, I_D = 32 * 512, NITEMS = I_IN + I_OUT + 2 * I_G + I_D;
        for (int it = gw; it < NITEMS; it += NGW) {
            int r = it;
            if (r < I_IN) { const int kb = r / 152, nb = r % 152; tr_item(w_in, NCOLS_IN, 64 * kb, 32 * nb, WIN + (size_t)(32 * nb) * DM, DM, scr, lane); continue; } r -= I_IN;
            if (r < I_OUT) { const int kb = r / 64, nb = r % 64; tr_item(w_out, DM, 64 * kb, 32 * nb, WOUT + (size_t)(32 * nb) * DM, DM, scr, lane); continue; } r -= I_OUT;
            if (r < 2 * I_G) { const int up = r >= I_G ? 1 : 0; r -= up * I_G; const int e = r / 512, q = r % 512, kb = q / 16, n0 = 32 * (q % 16), drow = 256 * (n0 >> 7) + (n0 & 127) + 128 * up;
                tr_item((up ? w_up : w_gate) + (size_t)e * DM * DEXP, DEXP, 64 * kb, n0, WGU + ((size_t)e * 1024 + drow) * DM, DM, scr, lane); continue; } r -= 2 * I_G;
            { const int e = r / 512, q = r % 512, kb = q / 64, n0 = 32 * (q % 64); tr_item(w_down + (size_t)e * DEXP * DM, DM, 64 * kb, n0, WDN + ((size_t)e * DM + n0) * DEXP, DEXP, scr, lane); }
        }
        for (int idx = gw * 64 + lane; idx < 256 * 256; idx += NGW * 64) {
            const int r = idx >> 8, k0 = (idx & 255) * 8; float v[8];
#pragma unroll
            for (int j = 0; j < 8; ++j) v[j] = r < 4 ? w_group[(k0 + j) * 4 + r] : (r < 36 ? w_expert[(k0 + j) * 32 + (r - 4)] : 0.f);
            v4u o; o.x = pk2(v[0], v[1]); o.y = pk2(v[2], v[3]); o.z = pk2(v[4], v[5]); o.w = pk2(v[6], v[7]); *(GAS v4u*)(WR + (size_t)r * DM + k0) = o;
        }
        if (BOTH(0)) GRID_BAR(0);
    }
    if (IN(1)) { kargp_t kp = KP(); norm_mod_rows(kp->in[0], kp->in[4], (const float*)WSP(kp, WS_MOD), 0, 1, (bf16*)WSP(kp, WS_XN), gw, NGW, lane); if (BOTH(1)) GRID_BAR(1); }
    if (IN(2)) {
        kargp_t kp = KP();
        pg8::Gemm g{(const bf16*)WSP(kp, WS_XN), (const bf16*)WSP(kp, WS_WIN), DM, DM}; pg8::StaticOrder S; S.init(M, NPROJ, G, bx);
        pg8::EpiProj E{(bf16*)WSP(kp, WS_PROJ), (float*)WSP(kp, WS_LOGF), kp->in[6], attn_body::C2};
        pg8::gemm_phase<pg8::EpiProj, pg8::StaticOrder, true>(lds + RING_OFF, g, S, E);
        if (BOTH(2)) GRID_BAR(2);
    }
    if (IN(3)) { kargp_t kp = KP(); for (int bh = bx; bh < 32; bh += G) scan_seq(lds, (const float*)WSP(kp, WS_LOGF), (float*)WSP(kp, WS_BIAS), bh, tid);
        knt_tiles((const bf16*)WSP(kp, WS_PROJ), (float*)WSP(kp, WS_KNT), gw, NGW, lane);
        if (BOTH(3)) GRID_BAR(3); }
    if (IN(4)) {
        kargp_t kp = KP();
        const attn_body::AttnArgs AT{(const attn_body::bf16*)WSP(kp, WS_PROJ), (attn_body::bf16*)WSP(kp, WS_OBUF), (const float*)WSP(kp, WS_BIAS), (const float*)WSP(kp, WS_KNT), kp->in[7], (unsigned*)WSP(kp, WS_CTL) + CW_QUEUE};
        attn_body::attn_phase<8>((char*)lds_raw + RING_OFF, AT, vcu, G);
        if (BOTH(4)) GRID_BAR(4);
    }
    if (IN(5)) { kargp_t kp = KP(); onorm_rows((bf16*)WSP(kp, WS_OBUF), kp->in[8], kp->in[9], gw, NGW, lane); if (BOTH(5)) GRID_BAR(5); }
    if (IN(6)) {
        kargp_t kp = KP();
        pg8::Gemm g{(const bf16*)WSP(kp, WS_OBUF), (const bf16*)WSP(kp, WS_WOUT), DM, DM}; pg8::StaticOrder S; S.init(M, DM, G, bx);
        pg8::EpiResGate E{kp->in[0], kp->out, (const float*)WSP(kp, WS_MOD)};
        pg8::gemm_phase<pg8::EpiResGate, pg8::StaticOrder, true>(lds + RING_OFF, g, S, E);
        if (BOTH(6)) GRID_BAR(6);
    }
    if (IN(7)) { kargp_t kp = KP(); norm_mod_rows(kp->out, kp->in[11], (const float*)WSP(kp, WS_MOD), 3, 4, (bf16*)WSP(kp, WS_XN), gw, NGW, lane); if (BOTH(7)) GRID_BAR(7); }
    if (IN(8)) {
        kargp_t kp = KP();
        pg8::Gemm g{(const bf16*)WSP(kp, WS_XN), (const bf16*)WSP(kp, WS_WR), DM, DM}; pg8::StaticOrder S; S.init(M, 256, G, bx);
        pg8::EpiRouter E{(float*)WSP(kp, WS_LOGITS)};
        pg8::gemm_phase<pg8::EpiRouter, pg8::StaticOrder, true>(lds + RING_OFF, g, S, E);
        if (BOTH(8)) GRID_BAR(8);
    }
    if (IN(9)) { kargp_t kp = KP();
        for (int t0 = bx * 64; t0 < M; t0 += G * 64) route_block(lds, (const float*)WSP(kp, WS_LOGITS), kp->in[13], kp->in[15], (gu32*)WSP(kp, WS_CTL) + CW_CNT, (int*)WSP(kp, WS_LIST), (int*)WSP(kp, WS_SLOT), (float*)WSP(kp, WS_EW), t0, tid);
        if (BOTH(9)) GRID_BAR(9); }
    if (IN(10)) {
        kargp_t kp = KP();
        moe_tables(lds + LDSCTL_OFF, (gu32*)WSP(kp, WS_CTL) + CW_CNT, tid);
        pg8::Gemm g{(const bf16*)WSP(kp, WS_XN), (const bf16*)WSP(kp, WS_WGU), DM, DM}; pg8::GroupedOrder S{(const LAS int*)(lds + LDSCTL_OFF), (const LAS int*)(lds + LDSCTL_OFF + 160), (const int*)WSP(kp, WS_LIST), 4, G, bx};
        pg8::EpiSwiGLU E{(bf16*)WSP(kp, WS_HID)};
        pg8::gemm_phase<pg8::EpiSwiGLU, pg8::GroupedOrder, true>(lds + RING_OFF, g, S, E);
        if (BOTH(10)) GRID_BAR(10);
    }
    if (IN(11)) {
        kargp_t kp = KP();
        moe_tables(lds + LDSCTL_OFF, (gu32*)WSP(kp, WS_CTL) + CW_CNT, tid);
        pg8::Gemm g{(const bf16*)WSP(kp, WS_HID), (const bf16*)WSP(kp, WS_WDN), DEXP, DEXP}; pg8::GroupedOrder S{(const LAS int*)(lds + LDSCTL_OFF), (const LAS int*)(lds + LDSCTL_OFF + 160), nullptr, 8, G, bx};
        pg8::EpiDown E{(bf16*)WSP(kp, WS_YS)};
        pg8::gemm_phase<pg8::EpiDown, pg8::GroupedOrder, true>(lds + RING_OFF, g, S, E);
        if (BOTH(11)) GRID_BAR(11);
    }
    if (IN(12)) {
        kargp_t kp = KP();
        moe_tables(lds + LDSCTL_OFF, (gu32*)WSP(kp, WS_CTL) + CW_CNT, tid);
        const unsigned bad = __hip_atomic_load(ctl + CW_TMO, RLX_AGENT) | __hip_atomic_load((gu32*)((unsigned*)(ctl + CW_BAR) + XB_TMO), RLX_AGENT);
        float* out = kp->out;
        final_rows(out, (const bf16*)WSP(kp, WS_YS), (const int*)WSP(kp, WS_SLOT), (const float*)WSP(kp, WS_EW), (const float*)WSP(kp, WS_MOD), kp->in[19], (const LAS int*)(lds + LDSCTL_OFF), gw, NGW, lane);
        if (bad && N_LAUNCHES != PER_PHASE) { const float qn = __builtin_nanf(""); for (int m = gw; m < M; m += NGW) out[(size_t)m * DM + lane] = qn; }
    }
#undef IN
#undef BOTH
}

extern "C" void kernel_launch(void* const* d_in, const int* in_sizes, int n_in, void* d_out, int out_size, void* d_ws, size_t ws_size, hipStream_t stream) {
    static int grid = 0;
    if (grid == 0) {
        if (n_in != 20 || in_sizes[0] != M * DM || out_size != M * DM || ws_size < WS_END) { fprintf(stderr, "kernel_launch: unexpected shapes or workspace (n_in %d, in0 %d, out %d, ws %zu < %zu); nothing launched\n", n_in, n_in > 0 ? in_sizes[0] : -1, out_size, ws_size, (size_t)WS_END); grid = -1; return; }
        int dev = 0, cus = 0, per_cu = 0;
        if (hipGetDevice(&dev) != hipSuccess || hipDeviceGetAttribute(&cus, hipDeviceAttributeMultiprocessorCount, dev) != hipSuccess) { fprintf(stderr, "kernel_launch: device query failed\n"); grid = -1; return; }
        if (hipFuncSetAttribute((const void*)fwd_kernel, hipFuncAttributeMaxDynamicSharedMemorySize, LDS_BYTES) != hipSuccess) { fprintf(stderr, "kernel_launch: hipFuncSetAttribute failed\n"); grid = -1; return; }
        if (hipOccupancyMaxActiveBlocksPerMultiprocessor(&per_cu, (const void*)fwd_kernel, NWAVES * 64, LDS_BYTES) != hipSuccess || per_cu < 1) fprintf(stderr, "kernel_launch: note: occupancy query reports %d workgroups per CU\n", per_cu);
        (void)hipGetLastError();
        grid = cus;
    }
    if (grid < 0) return;
    if (hipMemsetAsync((char*)d_ws + WS_CTL, 0, CTL_ZERO_BYTES, stream) != hipSuccess) { fprintf(stderr, "kernel_launch: hipMemsetAsync failed\n"); return; }
    Args a{};
    for (int i = 0; i < 20; ++i) a.in[i] = (const float*)d_in[i];
    a.out = (float*)d_out; a.ws = (unsigned char*)d_ws;
    for (int li = 0; li < N_LAUNCHES; ++li) {
        a.ph_lo = (N_LAUNCHES == PER_PHASE) ? li : 0; a.ph_hi = (N_LAUNCHES == PER_PHASE) ? li + 1 : PER_PHASE; a.li = li;
        hipLaunchKernelGGL(fwd_kernel, dim3(grid), dim3(NWAVES * 64), LDS_BYTES, stream, a);
        const hipError_t le = hipPeekAtLastError();
        if (le != hipSuccess) { fprintf(stderr, "kernel_launch: launch %d failed: %s\n", li, hipGetErrorName(le)); break; }
    }
}
```

```cpp
#include <hip/hip_runtime.h>
#include <hip/hip_bf16.h>
#include <cstdio>
#include <cstdint>
#include <cmath>
namespace pg8 {
#define PG8_LAS __attribute__((address_space(3)))
typedef unsigned short bf16_t;
typedef short bf16x8 __attribute__((ext_vector_type(8)));
typedef float f32x4 __attribute__((ext_vector_type(4)));
typedef unsigned u32x4 __attribute__((ext_vector_type(4)));
typedef int v4i_t __attribute__((ext_vector_type(4)));
constexpr int BM = 256, BK = 64, HALF = 128, HTB = HALF * BK * 2  , STAGE_BYTES = 8 * HTB, NXCD = 8, WGM = 8;
constexpr int LIST_CAP = 16384;

__host__ __device__ __forceinline__ int lds_byte(int r, int c) { const int st = (r >> 4) * 2 + (c >> 5), rr = r & 15, cc = c & 31, ob = rr * 64 + cc * 2; return st * 1024 + (ob ^ (((ob >> 9) & 1) << 5)); }
__host__ __device__ __forceinline__ void stage_rc(int b, int& R, int& C) { const int st = b / 1024, sb = b % 1024, swz = sb ^ (((sb >> 9) & 1) << 5); R = (st >> 1) * 16 + swz / 64; C = (st & 1) * 32 + (swz % 64) / 2; }
__host__ __device__ __forceinline__ int perm32(int rho) { const int n = rho >> 4, i = rho & 15; return 8 * (i >> 2) + 4 * n + (i & 3); }

struct Unit { int pm, pn, e, pl, nv; };
struct Gemm { const void* A; const void* Bt; int lda, K; };

struct StaticOrder {
    int nM, nN, nwg, G, c;
    __host__ __device__ void init(int M, int N, int G_, int c_) { nM = M / BM; nN = N / BM; nwg = nM * nN; G = G_; c = c_; }
    __host__ __device__ bool next(int i, Unit& u) const {
        const long L = (long)i * G + c; if (L >= nwg) return false;
        int wgid = (int)L; { const int q = nwg / NXCD, r = nwg % NXCD, xcd = wgid % NXCD, off = wgid / NXCD; wgid = (xcd < r ? xcd * (q + 1) : r * (q + 1) + (xcd - r) * q) + off; }
        const int nig = WGM * nN, gid = wgid / nig, fm = gid * WGM, gsz = (nM - fm) < WGM ? (nM - fm) : WGM;
        u.pm = fm + ((wgid % nig) % gsz); u.pn = (wgid % nig) / gsz; u.e = 0; u.pl = 0; u.nv = BM; return true;
    }
    __device__ __forceinline__ int arow(const Unit& u, int r) const { return u.pm * BM + r; }
    __device__ __forceinline__ void a_ready(const Unit&) const {}
    __device__ __forceinline__ void done(const Unit&) const {}
};
struct GroupedOrder {
    const PG8_LAS int* pfx; const PG8_LAS int* cnt; const int* list; int ntile, G, c;
    __device__ __forceinline__ bool next(int i, Unit& u) const {
        const int total = __builtin_amdgcn_readfirstlane(pfx[32]) * ntile; const long L = (long)i * G + c; if (L >= total) return false;
        const int pg = (int)L / ntile, pnl = (int)L % ntile; int e = 0;
#pragma unroll 8
        for (int j = 1; j < 32; ++j) e += (pg >= pfx[j]) ? 1 : 0;
        e = __builtin_amdgcn_readfirstlane(e);
        const int pl = pg - __builtin_amdgcn_readfirstlane(pfx[e]); const int rem = __builtin_amdgcn_readfirstlane(cnt[e]) - BM * pl;
        u.pm = pg; u.pn = e * ntile + pnl; u.e = e; u.pl = pl; u.nv = rem < BM ? rem : BM; return true;
    }
    __device__ __forceinline__ int arow(const Unit& u, int r) const { return list ? list[(size_t)u.e * LIST_CAP + u.pl * BM + (r < u.nv ? r : 0)] : u.pm * BM + r; }
    __device__ __forceinline__ void a_ready(const Unit&) const {}
    __device__ __forceinline__ void done(const Unit&) const {}
};

__device__ __forceinline__ unsigned cvt_pk_bf16(float lo, float hi) { unsigned r; asm volatile("v_cvt_pk_bf16_f32 %0, %1, %2" : "=v"(r) : "v"(lo), "v"(hi)); return r; }
__device__ __forceinline__ float log_sigmoid(float x) { return fminf(x, 0.f) - log1pf(expf(-fabsf(x))); }
__device__ __forceinline__ float silu_f(float g) { return g * __builtin_amdgcn_rcpf(1.0f + __builtin_amdgcn_exp2f(-1.4426950408889634f * g)); }

struct EpiProj {
    static constexpr bool PERM = true, AFTER_DRAIN = false;
    bf16_t* P; float* logf; const float* bfg; float qscale;
    __device__ __forceinline__ void operator()(const f32x4 (&acc)[2][2][4][2], const Unit& u, int wr, int wc, int fr, int fq) const {
        const int row0 = u.pm * BM + wr * 64 + fr;
        if (u.pn < 18) {
            const float sc = (u.pn < 4 || (u.pn >= 6 && u.pn < 10)) ? qscale : 1.f;
            const int col0 = u.pn * BM + wc * 32 + 8 * fq;
#pragma unroll
            for (int ai = 0; ai < 2; ++ai)
#pragma unroll
                for (int m = 0; m < 4; ++m) { bf16_t* rowp = P + (size_t)(row0 + ai * HALF + m * 16) * 4608 + col0;
#pragma unroll
                    for (int bj = 0; bj < 2; ++bj) { const f32x4 v0 = acc[ai][bj][m][0] * sc, v1 = acc[ai][bj][m][1] * sc;
                        u32x4 w; w.x = cvt_pk_bf16(v0[0], v0[1]); w.y = cvt_pk_bf16(v0[2], v0[3]); w.z = cvt_pk_bf16(v1[0], v1[1]); w.w = cvt_pk_bf16(v1[2], v1[3]);
                        *(u32x4*)(rowp + bj * HALF) = w; } }
        } else if (wc == 0 && fq < 2) {
#pragma unroll
            for (int n = 0; n < 2; ++n) { const int c0 = 8 * fq + 4 * n; const f32x4 bv = *(const f32x4*)(bfg + c0);
#pragma unroll
                for (int ai = 0; ai < 2; ++ai)
#pragma unroll
                    for (int m = 0; m < 4; ++m) { const f32x4 v = acc[ai][0][m][n] + bv; f32x4 o; o[0] = log_sigmoid(v[0]); o[1] = log_sigmoid(v[1]); o[2] = log_sigmoid(v[2]); o[3] = log_sigmoid(v[3]);
                        *(f32x4*)(logf + (size_t)(row0 + ai * HALF + m * 16) * 16 + c0) = o; } }
        }
    }
};
struct EpiResGate {
    static constexpr bool PERM = false, AFTER_DRAIN = false;
    const float* x; float* out; const float* mod;
    __device__ __forceinline__ void operator()(const f32x4 (&acc)[2][2][4][2], const Unit& u, int wr, int wc, int fr, int fq) const {
        const float* g = mod + (u.pm >= 32 ? 12288 : 0) + 2 * 2048; const int col0 = u.pn * BM + wc * 32 + 4 * fq;
        f32x4 gv[2][2];
#pragma unroll
        for (int bj = 0; bj < 2; ++bj)
#pragma unroll
            for (int n = 0; n < 2; ++n) gv[bj][n] = *(const f32x4*)(g + col0 + bj * HALF + n * 16);
#pragma unroll
        for (int ai = 0; ai < 2; ++ai)
#pragma unroll
            for (int m = 0; m < 4; ++m) { const size_t off = (size_t)(u.pm * BM + ai * HALF + wr * 64 + m * 16 + fr) * 2048 + col0;
#pragma unroll
                for (int bj = 0; bj < 2; ++bj)
#pragma unroll
                    for (int n = 0; n < 2; ++n) { const f32x4 xv = *(const f32x4*)(x + off + bj * HALF + n * 16); *(f32x4*)(out + off + bj * HALF + n * 16) = xv + gv[bj][n] * acc[ai][bj][m][n]; }
                asm volatile("" ::: "memory"); }
    }
};
struct EpiRouter {
    static constexpr bool PERM = false, AFTER_DRAIN = false;
    float* L;
    __device__ __forceinline__ void operator()(const f32x4 (&acc)[2][2][4][2], const Unit& u, int wr, int wc, int fr, int fq) const {
        if (wc < 2) {
#pragma unroll
            for (int ai = 0; ai < 2; ++ai)
#pragma unroll
                for (int m = 0; m < 4; ++m) { float* rp = L + (size_t)(u.pm * BM + ai * HALF + wr * 64 + m * 16 + fr) * 64 + wc * 32 + 4 * fq;
#pragma unroll
                    for (int n = 0; n < 2; ++n) *(f32x4*)(rp + n * 16) = acc[ai][0][m][n]; }
        }
    }
};
__device__ __forceinline__ unsigned pk4_fp8(float a, float b, float c, float d) { unsigned w = 0; w = __builtin_amdgcn_cvt_pk_fp8_f32(a, b, w, false); w = __builtin_amdgcn_cvt_pk_fp8_f32(c, d, w, true); return w; }
struct EpiSwiGLU {
    static constexpr bool PERM = true, AFTER_DRAIN = false;
    unsigned char* H; float ws;
    __device__ __forceinline__ void operator()(const f32x4 (&acc)[2][2][4][2], const Unit& u, int wr, int wc, int fr, int fq) const {
        asm volatile("" : "+v"(fr), "+v"(fq));
        const int col0 = (u.pn & 3) * 128 + wc * 32 + 8 * fq;
#pragma unroll
        for (int ai = 0; ai < 2; ++ai)
#pragma unroll
            for (int m = 0; m < 4; ++m) { unsigned char* rowp = H + (size_t)(u.pm * BM + ai * HALF + wr * 64 + m * 16 + fr) * 512 + col0;
                const f32x4 g0 = acc[ai][0][m][0] * ws, g1 = acc[ai][0][m][1] * ws, u0 = acc[ai][1][m][0] * ws, u1 = acc[ai][1][m][1] * ws;
                typedef unsigned u32x2 __attribute__((ext_vector_type(2))); u32x2 w;
                w.x = pk4_fp8(silu_f(g0[0]) * u0[0], silu_f(g0[1]) * u0[1], silu_f(g0[2]) * u0[2], silu_f(g0[3]) * u0[3]);
                w.y = pk4_fp8(silu_f(g1[0]) * u1[0], silu_f(g1[1]) * u1[1], silu_f(g1[2]) * u1[2], silu_f(g1[3]) * u1[3]);
                *(u32x2*)rowp = w; }
    }
};
struct EpiDown {
    static constexpr bool PERM = true, AFTER_DRAIN = false;
    bf16_t* Y; float ws;
    __device__ __forceinline__ void operator()(const f32x4 (&acc)[2][2][4][2], const Unit& u, int wr, int wc, int fr, int fq) const {
        asm volatile("" : "+v"(fr), "+v"(fq));
        const int col0 = (u.pn & 7) * BM + wc * 32 + 8 * fq;
#pragma unroll
        for (int ai = 0; ai < 2; ++ai)
#pragma unroll
            for (int m = 0; m < 4; ++m) { bf16_t* rowp = Y + (size_t)(u.pm * BM + ai * HALF + wr * 64 + m * 16 + fr) * 2048 + col0;
#pragma unroll
                for (int bj = 0; bj < 2; ++bj) { const f32x4 v0 = acc[ai][bj][m][0] * ws, v1 = acc[ai][bj][m][1] * ws;
                    u32x4 w; w.x = cvt_pk_bf16(v0[0], v0[1]); w.y = cvt_pk_bf16(v0[2], v0[3]); w.z = cvt_pk_bf16(v1[0], v1[1]); w.w = cvt_pk_bf16(v1[2], v1[3]);
                    *(u32x4*)(rowp + bj * HALF) = w; } }
    }
};

typedef int v8i_t __attribute__((ext_vector_type(8)));
template <bool F8> struct FragT { bf16x8 k[2]; };
template <> struct FragT<true> { v8i_t v; };
template <class Epi, class Sched, bool ALIGN_EPI, bool FP8 = false>
__device__ __forceinline__ void gemm_phase(PG8_LAS unsigned char* lds, const Gemm g, const Sched& S, const Epi& E) {
    const int tid = threadIdx.x, wid = __builtin_amdgcn_readfirstlane(tid >> 6), lane = tid & 63, wr = wid >> 2, wc = wid & 3, fr = lane & 15, fq = lane >> 4;
    int nt_ = g.K / 128; asm volatile("" : "+s"(nt_));
    const int K = g.K, nt = nt_, lda = g.lda;
    int RA[2], CA[2]; unsigned voffB[2];
#pragma unroll
    for (int i = 0; i < 2; ++i) { int R, C; stage_rc(tid * 16 + i * 8192, R, C); const int Rb = Epi::PERM ? ((R & ~31) + perm32(R & 31)) : R;
        RA[i] = R; CA[i] = C; voffB[i] = (unsigned)(Rb * K + 2 * C); }
    const size_t kstep = (size_t)(BK * 2);
    const size_t hstep = (size_t)HALF * K;
    const size_t tstep = 2 * hstep;
    const unsigned ldsw = (unsigned)wid * 1024u;
    const int aoff = lds_byte(wr * 64 + fr, fq * 8), boff = lds_byte(wc * 32 + fr, fq * 8);
    const char* const Ab = (const char*)g.A;
#define PG8_SA(b, h) (((b) * 2 + (h)) * HTB)
#define PG8_SB(b, h) ((4 + (b) * 2 + (h)) * HTB)
#define PG8_STAGE(bufoff, gbase, voff) do { _Pragma("unroll") for (int _i = 0; _i < 2; ++_i) \
        __builtin_amdgcn_global_load_lds((const unsigned*)((const char*)(gbase) + (voff)[_i]), (PG8_LAS unsigned*)(lds + (bufoff) + ldsw + _i * 8192), 16, 0, 0); } while (0)
#define PG8_LDF(dst, base) do { const v4i_t f0_ = *(const PG8_LAS v4i_t*)(base), f1_ = *(const PG8_LAS v4i_t*)((base) + 1024); \
        if constexpr (FP8) dst.v = __builtin_shufflevector(f0_, f1_, 0, 1, 2, 3, 4, 5, 6, 7); else { dst.k[0] = __builtin_bit_cast(bf16x8, f0_); dst.k[1] = __builtin_bit_cast(bf16x8, f1_); } } while (0)
#define PG8_LDA(dst, b, h) do { _Pragma("unroll") for (int m = 0; m < 4; ++m) PG8_LDF(dst[m], lds + PG8_SA(b, h) + aoff + m * 2048); } while (0)
#define PG8_LDB(dst, b, h) do { _Pragma("unroll") for (int n = 0; n < 2; ++n) PG8_LDF(dst[n], lds + PG8_SB(b, h) + boff + n * 2048); } while (0)
#define PG8_MMA(ai, bj, At, Bt) do { __builtin_amdgcn_s_setprio(1); \
        if constexpr (FP8) { asm volatile("s_nop 4\n\t" \
            "v_mfma_f32_16x16x128_f8f6f4 %0, %8, %10, %0\n\t" \
            "v_mfma_f32_16x16x128_f8f6f4 %1, %9, %10, %1\n\t" \
            "v_mfma_f32_16x16x128_f8f6f4 %2, %8, %11, %2\n\t" \
            "v_mfma_f32_16x16x128_f8f6f4 %3, %9, %11, %3\n\t" \
            "v_mfma_f32_16x16x128_f8f6f4 %4, %8, %12, %4\n\t" \
            "v_mfma_f32_16x16x128_f8f6f4 %5, %9, %12, %5\n\t" \
            "v_mfma_f32_16x16x128_f8f6f4 %6, %8, %13, %6\n\t" \
            "v_mfma_f32_16x16x128_f8f6f4 %7, %9, %13, %7\n\t" \
            : "+v"(acc[ai][bj][0][0]), "+v"(acc[ai][bj][0][1]), "+v"(acc[ai][bj][1][0]), "+v"(acc[ai][bj][1][1]), "+v"(acc[ai][bj][2][0]), "+v"(acc[ai][bj][2][1]), "+v"(acc[ai][bj][3][0]), "+v"(acc[ai][bj][3][1]) \
            : "v"(Bt[0].v), "v"(Bt[1].v), "v"(At[0].v), "v"(At[1].v), "v"(At[2].v), "v"(At[3].v)); } \
        else { _Pragma("unroll") for (int m = 0; m < 4; ++m) _Pragma("unroll") for (int n = 0; n < 2; ++n) _Pragma("unroll") for (int k = 0; k < 2; ++k) \
            acc[ai][bj][m][n] = __builtin_amdgcn_mfma_f32_16x16x32_bf16(Bt[n].k[k], At[m].k[k], acc[ai][bj][m][n], 0, 0, 0); } __builtin_amdgcn_s_setprio(0); } while (0)
#define PG8_WAIT_V(n) asm volatile("s_waitcnt vmcnt(" #n ")" ::: "memory")
#define PG8_WAIT_L(n) asm volatile("s_waitcnt lgkmcnt(" #n ")" ::: "memory")
#define PG8_BAR __builtin_amdgcn_s_barrier()
#define PG8_SCHED __builtin_amdgcn_sched_barrier(0)
#define PG8_AOFF(dst, u) do { _Pragma("unroll") for (int _h = 0; _h < 2; ++_h) _Pragma("unroll") for (int _i = 0; _i < 2; ++_i) \
        dst[_h][_i] = (unsigned)S.arow(u, _h * HALF + RA[_i]) * (unsigned)lda + 2u * (unsigned)CA[_i]; } while (0)
    Unit cur, nxt; int ui = 0;
    if (!S.next(0, cur)) return;
    f32x4 acc[2][2][4][2];
#pragma unroll
    for (int a = 0; a < 2; ++a)
#pragma unroll
        for (int b = 0; b < 2; ++b)
#pragma unroll
            for (int m = 0; m < 4; ++m)
#pragma unroll
                for (int n = 0; n < 2; ++n) acc[a][b][m][n] = (f32x4){0.f, 0.f, 0.f, 0.f};
    FragT<FP8> At[4], B0[2], B1[2];
    unsigned ca[2][2], na[2][2];
    PG8_AOFF(ca, cur);
    const char* cB = (const char*)g.Bt + (size_t)cur.pn * tstep;
    S.a_ready(cur);
    PG8_STAGE(PG8_SB(0, 0), cB, voffB); PG8_STAGE(PG8_SB(0, 1), cB + hstep, voffB); PG8_STAGE(PG8_SA(0, 0), Ab, ca[0]); PG8_STAGE(PG8_SA(0, 1), Ab, ca[1]);
    if (wr == 1) PG8_BAR;
    PG8_WAIT_V(2); PG8_BAR;
    PG8_STAGE(PG8_SB(1, 0), cB + kstep, voffB); PG8_STAGE(PG8_SA(1, 0), Ab + kstep, ca[0]); PG8_STAGE(PG8_SB(1, 1), cB + hstep + kstep, voffB);
    PG8_WAIT_V(6); PG8_BAR;
    for (;;) {
        const bool has_next = S.next(ui + 1, nxt);
        if (has_next) { PG8_AOFF(na, nxt); } else { na[0][0] = ca[0][0]; na[0][1] = ca[0][1]; na[1][0] = ca[1][0]; na[1][1] = ca[1][1]; }
        const char* nB = has_next ? (const char*)g.Bt + (size_t)nxt.pn * tstep : cB;
#pragma nounroll
        for (int t = 0; t < nt; t += 2) {
            const bool last = (t == nt - 2);
            const char* a1 = Ab + (size_t)(t + 1) * kstep;
            const char* a2 = last ? Ab : Ab + (size_t)(t + 2) * kstep; const char* b2 = last ? nB : cB + (size_t)(t + 2) * kstep;
            const char* a3 = a2 + kstep; const char* b3 = b2 + kstep;
            unsigned o0[2], o1[2]; o0[0] = last ? na[0][0] : ca[0][0]; o0[1] = last ? na[0][1] : ca[0][1]; o1[0] = last ? na[1][0] : ca[1][0]; o1[1] = last ? na[1][1] : ca[1][1];
            if (last && has_next) S.a_ready(nxt);
            PG8_LDB(B0, 0, 0); PG8_LDB(B1, 0, 1); PG8_SCHED; PG8_LDA(At, 0, 0); PG8_STAGE(PG8_SA(1, 1), a1, ca[1]);
            PG8_WAIT_V(8); PG8_WAIT_L(0); PG8_BAR; PG8_MMA(0, 0, At, B0); PG8_MMA(0, 1, At, B1); PG8_BAR; PG8_SCHED;
            PG8_LDA(At, 0, 1); PG8_STAGE(PG8_SB(0, 0), b2, voffB); PG8_STAGE(PG8_SB(0, 1), b2 + hstep, voffB); PG8_STAGE(PG8_SA(0, 0), a2, o0);
            PG8_WAIT_V(8); PG8_WAIT_L(0); PG8_BAR; PG8_MMA(1, 0, At, B0); PG8_MMA(1, 1, At, B1); PG8_BAR; PG8_SCHED;
            PG8_LDB(B0, 1, 0); PG8_LDB(B1, 1, 1); PG8_SCHED; PG8_LDA(At, 1, 0); PG8_STAGE(PG8_SA(0, 1), a2, o1);
            PG8_WAIT_V(8); PG8_WAIT_L(0); PG8_BAR; PG8_MMA(0, 0, At, B0); PG8_MMA(0, 1, At, B1); PG8_BAR; PG8_SCHED;
            PG8_LDA(At, 1, 1); PG8_STAGE(PG8_SB(1, 0), b3, voffB); PG8_STAGE(PG8_SB(1, 1), b3 + hstep, voffB); PG8_STAGE(PG8_SA(1, 0), a3, o0);
            PG8_WAIT_V(8); PG8_WAIT_L(0); PG8_BAR; PG8_MMA(1, 0, At, B0); PG8_MMA(1, 1, At, B1); PG8_BAR; PG8_SCHED;
        }
        if constexpr (ALIGN_EPI) { if (wr == 0) PG8_BAR; }
        if constexpr (FP8) asm volatile("s_nop 15\n\ts_nop 7" ::: "memory");
        E(acc, cur, wr, wc, fr, fq); S.done(cur);
        if (!has_next) break;
#pragma unroll
        for (int a = 0; a < 2; ++a)
#pragma unroll
            for (int b = 0; b < 2; ++b)
#pragma unroll
                for (int m = 0; m < 4; ++m)
#pragma unroll
                    for (int n = 0; n < 2; ++n) acc[a][b][m][n] = (f32x4){0.f, 0.f, 0.f, 0.f};
        cur = nxt; cB = nB; ++ui; ca[0][0] = na[0][0]; ca[0][1] = na[0][1]; ca[1][0] = na[1][0]; ca[1][1] = na[1][1];
        if constexpr (ALIGN_EPI) { if (wr == 1) PG8_BAR; }
    }
    PG8_WAIT_V(0);
    if constexpr (!ALIGN_EPI) { if (wr == 0) PG8_BAR; }
    PG8_BAR;
#undef PG8_SA
#undef PG8_SB
#undef PG8_STAGE
#undef PG8_LDA
#undef PG8_LDB
#undef PG8_MMA
#undef PG8_LDF
#undef PG8_WAIT_V
#undef PG8_WAIT_L
#undef PG8_BAR
#undef PG8_SCHED
#undef PG8_AOFF
}
}
#include <hip/hip_bf16.h>
#include <cmath>
namespace attn_body {
using bf16=__hip_bfloat16;
using bf16x8=__attribute__((ext_vector_type(8)))short;
using s16x4=__attribute__((ext_vector_type(4)))short;
using f32x16=__attribute__((ext_vector_type(16)))float;
using u32x4=__attribute__((ext_vector_type(4)))unsigned;
constexpr int BATCH=2,NHEAD=16,SEQ=8192,D=64,PP=4608,OP=2048;
constexpr int NW=8,QBLK=32,QB=QBLK*NW,KVBLK=64,NQB=SEQ/QB;
constexpr int ATTN_UNIT_ROWS=QB;
__device__ __forceinline__ int crow(int r,int hi){return (r&3)+8*(r>>2)+4*hi;}
#define SBAR() __builtin_amdgcn_sched_barrier(0)
__device__ __forceinline__ void cmask(f32x16&p0,f32x16&p1,int jb,int qrel,int hi){
  const float NEG=-INFINITY; int kb=64*jb+4*hi;
  #pragma unroll
  for(int r=0;r<16;++r){int kv=kb+(r&3)+8*(r>>2); if(kv>qrel)p0[r]=NEG; if(kv+32>qrel)p1[r]=NEG;}
}

typedef float f32x4v __attribute__((ext_vector_type(4)));
__device__ __forceinline__ void swamask(f32x16&p0,f32x16&p1,int kb0,int qrel,int hi){
  const float NEG=-INFINITY; const int d0=qrel-kb0-4*hi;
  #pragma unroll
  for(int r=0;r<16;++r){const int d=d0-((r&3)+8*(r>>2)); if((unsigned)d>=128u)p0[r]=NEG; if((unsigned)(d-32)>=128u)p1[r]=NEG;}
}
constexpr int NSLOT=3, SLOTB=8192;
constexpr int LDS_K=0, LDS_V=NSLOT*SLOTB, LDS_WS=2*NSLOT*SLOTB, LDS_OST=LDS_WS+NW*64*4, LDS_BIAS=LDS_OST+NW*4096, LDS_MISC=LDS_BIAS+SEQ*4, LDS_BYTES=LDS_MISC+128;
constexpr float C2=0.125f*1.4426950408889634f;
__device__ __forceinline__ void glds16(const void*gsrc,unsigned lds_dst){unsigned keep;
  asm volatile("s_mov_b32 %0, m0\n\ts_mov_b32 m0, %2\n\ts_nop 0\n\tglobal_load_lds_dwordx4 %1, off\n\ts_mov_b32 m0, %0":"=&s"(keep):"v"(gsrc),"s"(lds_dst):"memory");}
__device__ __forceinline__ float max3f(float a,float b,float c){float r;asm("v_max3_f32 %0, %1, %2, %3":"=v"(r):"v"(a),"v"(b),"v"(c));return r;}
__device__ __forceinline__ float max2f(float a,float b){float r;asm("v_max_f32_e32 %0, %1, %2":"=v"(r):"v"(a),"v"(b));return r;}
__device__ __forceinline__ float fadd_s(float a,float b){float r;asm("v_add_f32_e32 %0, %1, %2":"=v"(r):"v"(a),"v"(b));return r;}
__device__ __forceinline__ float fsub_s(float a,float b){float r;asm("v_sub_f32_e32 %0, %1, %2":"=v"(r):"v"(a),"v"(b));return r;}
typedef float f32x2_t __attribute__((ext_vector_type(2))); typedef __bf16 bf16x2_t __attribute__((ext_vector_type(2)));
__device__ __forceinline__ unsigned cvtpk_s(float lo,float hi){f32x2_t v={lo,hi};bf16x2_t b=__builtin_convertvector(v,bf16x2_t);return __builtin_bit_cast(unsigned,b);}
#define WAIT_BAR(N) asm volatile("s_waitcnt vmcnt(" #N ") lgkmcnt(0)\n\ts_barrier":::"memory")

__device__ __forceinline__ void qkt(f32x16&p0,f32x16&p1,const char*Kslot,const bf16x8*qr,int r32,int hi){
  const char*kb=Kslot+hi*1024+r32*16;
  #pragma unroll
  for(int d0=0;d0<4;++d0){
    const bf16x8 b0=*reinterpret_cast<const bf16x8*>(kb+d0*2048);
    const bf16x8 b1=*reinterpret_cast<const bf16x8*>(kb+d0*2048+512);
    p0=__builtin_amdgcn_mfma_f32_32x32x16_bf16(b0,qr[d0],p0,0,0,0);p1=__builtin_amdgcn_mfma_f32_32x32x16_bf16(b1,qr[d0],p1,0,0,0);}
}
typedef __attribute__((address_space(3))) const char* lds_cptr;
typedef short v4i16_t __attribute__((ext_vector_type(4)));
__device__ __forceinline__ void kload8(bf16x8*kf,lds_cptr kp){
  kf[0]=*(const __attribute__((address_space(3))) bf16x8*)(kp);      kf[1]=*(const __attribute__((address_space(3))) bf16x8*)(kp+512);
  kf[2]=*(const __attribute__((address_space(3))) bf16x8*)(kp+2048); kf[3]=*(const __attribute__((address_space(3))) bf16x8*)(kp+2560);
  kf[4]=*(const __attribute__((address_space(3))) bf16x8*)(kp+4096); kf[5]=*(const __attribute__((address_space(3))) bf16x8*)(kp+4608);
  kf[6]=*(const __attribute__((address_space(3))) bf16x8*)(kp+6144); kf[7]=*(const __attribute__((address_space(3))) bf16x8*)(kp+6656);
}
__device__ __forceinline__ void kload2(bf16x8*kf,lds_cptr kp,int j){ kf[2*j]=*(const __attribute__((address_space(3))) bf16x8*)(kp+j*2048); kf[2*j+1]=*(const __attribute__((address_space(3))) bf16x8*)(kp+j*2048+512); }
__device__ __forceinline__ s16x4 vtr(lds_cptr p){ return __builtin_bit_cast(s16x4,__builtin_amdgcn_ds_read_tr16_b64_v4i16((__attribute__((address_space(3))) v4i16_t*)p)); }
__device__ __forceinline__ float rowmax(const f32x16&p0,const f32x16&p1){
  float a=max3f(p0[0],p0[1],p1[0]),b=max3f(p0[2],p0[3],p1[1]);a=max3f(a,p1[2],p1[3]);
  #pragma unroll
  for(int r=4;r<16;r+=4){a=max3f(a,p0[r],p0[r+1]);b=max3f(b,p0[r+2],p0[r+3]);a=max3f(a,p1[r],p1[r+1]);b=max3f(b,p1[r+2],p1[r+3]);}
  const float m=max2f(a,b);
  auto rr=__builtin_amdgcn_permlane32_swap(__float_as_uint(m),__float_as_uint(m),false,false);
  return max2f(__uint_as_float(rr[0]),__uint_as_float(rr[1]));
}
__device__ __forceinline__ void pv(f32x16*o,int vb,bf16x8 pa0,bf16x8 pa1,bf16x8 pa2,bf16x8 pa3){
  #pragma unroll
  for(int d0=0;d0<2;++d0){s16x4 lo[4],hi[4];
    #pragma unroll
    for(int ks=0;ks<4;++ks){
      asm volatile("ds_read_b64_tr_b16 %0,%1 offset:%c2":"=&v"(lo[ks]):"v"(vb),"i"(d0*4096+ks*1024):"memory");
      asm volatile("ds_read_b64_tr_b16 %0,%1 offset:%c2":"=&v"(hi[ks]):"v"(vb),"i"(d0*4096+ks*1024+512):"memory");}
    asm volatile("s_waitcnt lgkmcnt(0)":::"memory");SBAR();
    #define PK(k) (bf16x8){lo[k][0],lo[k][1],lo[k][2],lo[k][3],hi[k][0],hi[k][1],hi[k][2],hi[k][3]}
    o[d0]=__builtin_amdgcn_mfma_f32_32x32x16_bf16(pa0,PK(0),o[d0],0,0,0);
    o[d0]=__builtin_amdgcn_mfma_f32_32x32x16_bf16(pa1,PK(1),o[d0],0,0,0);
    o[d0]=__builtin_amdgcn_mfma_f32_32x32x16_bf16(pa2,PK(2),o[d0],0,0,0);
    o[d0]=__builtin_amdgcn_mfma_f32_32x32x16_bf16(pa3,PK(3),o[d0],0,0,0);
    #undef PK
  }
}

#ifndef ATTN_STORE16
#define ATTN_STORE16(p,v) (*(u32x4*)(p)=(v))
#endif
template<int MODE,int THRL> __device__ __forceinline__ void attn_unit(int qb,const bf16*Qh,const bf16*__restrict__ Kh,const bf16*__restrict__ Vh,bf16*Oh,const float*__restrict__ biasg,const float*__restrict__ knt,float slope2,float sink2,char*shm){
  const int tid=threadIdx.x,lane=tid&63,r32=lane&31,hi=lane>>5; const int wid=__builtin_amdgcn_readfirstlane(tid>>6);
  const int q0=qb*QB;
  const bf16*Qw=Qh+(long)(q0+wid*QBLK)*PP;
  const lds_cptr shm3=(lds_cptr)shm; const int qrel=wid*QBLK+r32;
  bf16x8 qr[4];
  #pragma unroll
  for(int d0=0;d0<4;++d0)qr[d0]=*reinterpret_cast<const bf16x8*>(&Qw[(long)r32*PP+d0*16+hi*8]);
  int T0=(MODE==1)?(qb?4*qb-2:0):0;
  int NT=(MODE==1)?(qb?6:4):(q0+QB)/KVBLK;
  float ref=0.f;
  if(MODE==0){
    ref=biasg[q0];
    const int NTF=NT; const bf16*Kq=Kh+(long)(q0+qrel)*PP; float qn2=0.f,dot=0.f;
    #pragma unroll
    for(int d0=0;d0<4;++d0){ const bf16x8 kq=*reinterpret_cast<const bf16x8*>(&Kq[d0*16+hi*8]);
      #pragma unroll
      for(int e=0;e<8;++e){ const float qf=__builtin_bit_cast(float,(unsigned)(unsigned short)qr[d0][e]<<16), kf_=__builtin_bit_cast(float,(unsigned)(unsigned short)kq[e]<<16); qn2+=qf*qf; dot+=qf*kf_; } }
    { auto rr=__builtin_amdgcn_permlane32_swap(__float_as_uint(qn2),__float_as_uint(qn2),false,false); qn2=__uint_as_float(rr[0])+__uint_as_float(rr[1]); }
    { auto rr=__builtin_amdgcn_permlane32_swap(__float_as_uint(dot),__float_as_uint(dot),false,false); dot=__uint_as_float(rr[0])+__uint_as_float(rr[1]); }
    float qn=sqrtf(qn2), lb=dot+(biasg[q0+qrel]-ref);
    #pragma unroll
    for(int o_=1;o_<32;o_<<=1){ qn=fmaxf(qn,__shfl_xor(qn,o_)); lb=fminf(lb,__shfl_xor(lb,o_)); }
    __attribute__((address_space(3))) float*red=(__attribute__((address_space(3))) float*)(shm3+LDS_MISC); __attribute__((address_space(3))) int*redi=(__attribute__((address_space(3))) int*)(shm3+LDS_MISC);
    if(lane==0){ red[wid]=qn; red[8+wid]=lb; } if(tid==0)redi[16]=NTF-4;
    asm volatile("s_waitcnt lgkmcnt(0)\n\ts_barrier":::"memory");
    float QN=red[0],LB=red[8];
    #pragma unroll
    for(int w_=1;w_<NW;++w_){ QN=fmaxf(QN,red[w_]); LB=fminf(LB,red[8+w_]); }
    if(tid<NTF-4){ const float ub=QN*1.01f*knt[tid]+(biasg[KVBLK*tid+KVBLK-1]-ref); if(!(ub<LB-40.0f))__hip_atomic_fetch_min(&redi[16],tid,__ATOMIC_RELAXED,__HIP_MEMORY_SCOPE_WORKGROUP); }
    asm volatile("s_waitcnt lgkmcnt(0)\n\ts_barrier":::"memory");
    T0=__builtin_amdgcn_readfirstlane(redi[16])&~1; NT=NTF-T0;
  }
  const unsigned lds0=(unsigned)(uintptr_t)shm;
  float*wsf=(float*)(shm+LDS_WS)+wid*64;
  const bf16*ksrc=Kh+(long)(T0*KVBLK+lane)*PP+wid*8;
  const bf16*vsrc=Vh+(long)(T0*KVBLK+16*(wid&3)+(lane>>2))*PP+(wid>>2)*32+(lane&3)*8;
  const unsigned kdst=lds0+LDS_K+wid*1024, vdst=lds0+LDS_V+wid*1024;
  #define DMA_K(t,slot) glds16(ksrc+(long)(t)*KVBLK*PP,(unsigned)__builtin_amdgcn_readfirstlane(kdst+(slot)))
  #define DMA_V(t,slot) glds16(vsrc+(long)(t)*KVBLK*PP,(unsigned)__builtin_amdgcn_readfirstlane(vdst+(slot)))
  const int vb0=(int)(lds0+LDS_V)+((lane>>4)&1)*32+(lane&3)*8+(4*hi+((lane&15)>>2))*64;
  const char*Kbase=shm+LDS_K; bf16x8 kf[8];
  const lds_cptr kp0=shm3+LDS_K+hi*1024+r32*16; const lds_cptr vp0=shm3+LDS_V+((lane>>4)&1)*32+(lane&3)*8+(4*hi+((lane&15)>>2))*64;
  DMA_K(0,0);DMA_V(0,0);DMA_K(1,SLOTB);
  float mhat=0.f,l_reg=0.f;f32x16 o[2];o[0]=f32x16{};o[1]=f32x16{};
  { __attribute__((address_space(3))) float*Tb=(__attribute__((address_space(3))) float*)(shm3+LDS_BIAS);
    if(MODE==0){ for(int k=tid;k<NT*KVBLK;k+=NW*64)Tb[k]=biasg[T0*KVBLK+k]-ref; }
    else{ const int koff=T0*KVBLK-q0; for(int k=tid;k<NT*KVBLK;k+=NW*64)Tb[k]=slope2*(float)(k+koff); } }
  const __attribute__((address_space(3))) f32x4v*Tl=(const __attribute__((address_space(3))) f32x4v*)(shm3+LDS_BIAS)+hi;
  const float sinkc=sink2+slope2*(float)qrel;
  #define CMASK(P0,P1,t) do{ if(MODE==1){ swamask(P0,P1,(T0+(t))*KVBLK-q0,qrel,hi); } else { int jb_=(t)-(NT-4); if(jb_>=0)cmask(P0,P1,jb_,qrel,hi); } }while(0)
  bool resc=false;
  #define START(P0,P1) do{ float rm=rowmax(P0,P1); if(MODE==1)rm=max2f(rm,sinkc); resc=false; \
    { const float dl=rm; mhat=fadd_s(mhat,dl); \
      _Pragma("unroll") for(int r=0;r<16;++r){P0[r]=fsub_s(P0[r],dl);P1[r]=fsub_s(P1[r],dl);} } \
    _Pragma("unroll") for(int r=0;r<16;++r)P0[r]=__builtin_amdgcn_exp2f(P0[r]); }while(0)
  #define RESC() do{ if(resc){ asm volatile("s_waitcnt lgkmcnt(0)":::"memory"); \
      _Pragma("unroll") for(int d_=0;d_<2;++d_) _Pragma("unroll") for(int r=0;r<16;++r)o[d_][r]*=wsf[crow(r,hi)]; } }while(0)
  #define BL0(X0,t,g_) do{ const f32x4v a_=Tl[(t)*16+2*(g_)]; X0[4*(g_)]=a_[0];X0[4*(g_)+1]=a_[1];X0[4*(g_)+2]=a_[2];X0[4*(g_)+3]=a_[3]; }while(0)
  #define BL1(X1,t,g_) do{ const f32x4v b_=Tl[(t)*16+8+2*(g_)]; X1[4*(g_)]=b_[0];X1[4*(g_)+1]=b_[1];X1[4*(g_)+2]=b_[2];X1[4*(g_)+3]=b_[3]; }while(0)
  #define BLALL(X0,X1,t) do{ BL0(X0,t,0);BL0(X0,t,1);BL0(X0,t,2);BL0(X0,t,3);BL1(X1,t,0);BL1(X1,t,1);BL1(X1,t,2);BL1(X1,t,3); }while(0)
  #define SUBM(X0,X1) do{ _Pragma("unroll") for(int r=0;r<16;++r){X0[r]-=mhat;X1[r]-=mhat;} }while(0)
  f32x16 pA0,pA1,pB0,pB1;
  int sl_prev=0,sl_cur=0,sl_next=SLOTB;
  #define ROT() do{sl_prev=sl_cur;sl_cur=sl_next;sl_next=(sl_next==(NSLOT-1)*SLOTB)?0:sl_next+SLOTB;}while(0)
  DMA_K(2,2*SLOTB);
  WAIT_BAR(3);
  BLALL(pA0,pA1,0);
  qkt(pA0,pA1,Kbase,qr,r32,hi);asm volatile("s_nop 15\n\ts_nop 7":"+v"(pA0),"+v"(pA1));CMASK(pA0,pA1,0);
  START(pA0,pA1);
  _Pragma("unroll") for(int r=0;r<16;++r)pA1[r]=__builtin_amdgcn_exp2f(pA1[r]);
  BLALL(pB0,pB1,1);
  WAIT_BAR(0);
  DMA_K(3,0);DMA_V(1,SLOTB);
  ROT();
  kload8(kf,kp0+sl_cur);
  WAIT_BAR(2);
  s16x4 vlo[8],vhi[8]; u32x4 pw0,pw1,pw2,pw3;
  #define PKW(P,B) cvtpk_s(P[B],P[B+1])
  #define PAF(k) __builtin_bit_cast(bf16x8,pw##k)
  #define VFR(i) (bf16x8){vlo[i][0],vlo[i][1],vlo[i][2],vlo[i][3],vhi[i][0],vhi[i][1],vhi[i][2],vhi[i][3]}
  #define PIN(x) asm volatile("":"+v"(x))
  #define MX3(a,b,c) __builtin_fmaxf(__builtin_fmaxf((a),(b)),(c))
  #define GAPA(MF,A0,A1,A2,A3,W0,W1,PW) do{ MF; sacc+=A0; sacc+=A1; sacc+=A2; sacc+=A3; PIN(sacc); W0; W1; PIN(PW); SBAR(); }while(0)
  #define EX(v) __builtin_amdgcn_exp2f(v)
  #define GAPB(MF,X,B) do{ MF; X[B]=EX(X[B]); X[B+1]=EX(X[B+1]); X[B+2]=EX(X[B+2]); X[B+3]=EX(X[B+3]); PIN(X); SBAR(); }while(0)
  #define VRD(i) do{ vlo[i]=vtr(vp_+(((i)>>2)*4096+((i)&3)*1024)); vhi[i]=vtr(vp_+(((i)>>2)*4096+((i)&3)*1024+512)); }while(0)
  #define KRD(G,j) do{ if(G){ kload2(kf,kp0+sl_next,j); SBAR(); } }while(0)
  #define BLD(G,LD) do{ if(G){ LD; SBAR(); } }while(0)
  #define STEP(C0,C1,P0,P1,t,GK,GV,GL) do{ SBAR(); SUBM(C0,C1); SBAR(); \
    const lds_cptr vp_=vp0+sl_prev; \
    VRD(0); SBAR(); float sacc=(P0[0]+P0[1]); \
    GAPA(C0=__builtin_amdgcn_mfma_f32_32x32x16_bf16(kf[0],qr[0],C0,0,0,0), P0[2],P0[3],P0[4],P0[5],     pw0[0]=PKW(P0,0), pw0[1]=PKW(P0,2), pw0); \
    VRD(4); SBAR(); GAPA(C1=__builtin_amdgcn_mfma_f32_32x32x16_bf16(kf[1],qr[0],C1,0,0,0), P0[6],P0[7],P0[8],P0[9],     pw0[2]=PKW(P0,4), pw0[3]=PKW(P0,6), pw0); \
    VRD(1); SBAR(); GAPA(C0=__builtin_amdgcn_mfma_f32_32x32x16_bf16(kf[2],qr[1],C0,0,0,0),   P0[10],P0[11],P0[12],P0[13], pw1[0]=PKW(P0,8), pw1[1]=PKW(P0,10), pw1); \
    VRD(5); SBAR(); GAPA(C1=__builtin_amdgcn_mfma_f32_32x32x16_bf16(kf[3],qr[1],C1,0,0,0),   P0[14],P0[15],P1[0],P1[1],   pw1[2]=PKW(P0,12),pw1[3]=PKW(P0,14), pw1); \
    VRD(2); SBAR(); GAPA(C0=__builtin_amdgcn_mfma_f32_32x32x16_bf16(kf[4],qr[2],C0,0,0,0),   P1[2],P1[3],P1[4],P1[5],     pw2[0]=PKW(P1,0), pw2[1]=PKW(P1,2), pw2); \
    VRD(6); SBAR(); GAPA(C1=__builtin_amdgcn_mfma_f32_32x32x16_bf16(kf[5],qr[2],C1,0,0,0),   P1[6],P1[7],P1[8],P1[9],     pw2[2]=PKW(P1,4), pw2[3]=PKW(P1,6), pw2); \
    VRD(3); SBAR(); GAPA(C0=__builtin_amdgcn_mfma_f32_32x32x16_bf16(kf[6],qr[3],C0,0,0,0),   P1[10],P1[11],P1[12],P1[13], pw3[0]=PKW(P1,8), pw3[1]=PKW(P1,10), pw3); \
    VRD(7); SBAR(); GAPA(C1=__builtin_amdgcn_mfma_f32_32x32x16_bf16(kf[7],qr[3],C1,0,0,0),   P1[14],P1[15],0.f,0.f,       pw3[2]=PKW(P1,12),pw3[3]=PKW(P1,14), pw3); \
    l_reg+=sacc; \
    if(GK){DMA_K((t)+3,sl_cur);} if(GV){DMA_V((t)+1,sl_next);} \
    CMASK(C0,C1,t); \
    { float a=MX3(C0[0],C0[1],C1[0]),b=MX3(C0[2],C0[3],C1[1]); a=MX3(a,C1[2],C1[3]); \
      _Pragma("unroll") for(int r=4;r<16;r+=4){a=MX3(a,C0[r],C0[r+1]);b=MX3(b,C0[r+2],C0[r+3]);a=MX3(a,C1[r],C1[r+1]);b=MX3(b,C1[r+2],C1[r+3]);} \
      float rm=__builtin_fmaxf(a,b); { auto rr=__builtin_amdgcn_permlane32_swap(__float_as_uint(rm),__float_as_uint(rm),false,false); rm=__builtin_fmaxf(__uint_as_float(rr[0]),__uint_as_float(rr[1])); } \
      resc=false; \
      if(__builtin_expect(__any(rm>(float)THRL),0)){ const float dl=__builtin_fmaxf(rm,0.f); mhat+=dl; \
        _Pragma("unroll") for(int r=0;r<16;++r){C0[r]-=dl;C1[r]-=dl;} \
        const float f=__builtin_amdgcn_exp2f(-dl); l_reg*=f; if(hi==0)wsf[r32]=f; resc=true; } } \
    SBAR(); \
    BLD(GL,BL0(P0,(t)+1,0);BL0(P0,(t)+1,1)); GAPB(o[0]=__builtin_amdgcn_mfma_f32_32x32x16_bf16(PAF(0),VFR(0),o[0],0,0,0), C0,0); \
    BLD(GL,BL0(P0,(t)+1,2);BL0(P0,(t)+1,3)); GAPB(o[1]=__builtin_amdgcn_mfma_f32_32x32x16_bf16(PAF(0),VFR(4),o[1],0,0,0), C0,4); \
    KRD(GL,0); GAPB(o[0]=__builtin_amdgcn_mfma_f32_32x32x16_bf16(PAF(1),VFR(1),o[0],0,0,0), C0,8); \
    KRD(GL,1); GAPB(o[1]=__builtin_amdgcn_mfma_f32_32x32x16_bf16(PAF(1),VFR(5),o[1],0,0,0), C0,12); \
    KRD(GL,2); GAPB(o[0]=__builtin_amdgcn_mfma_f32_32x32x16_bf16(PAF(2),VFR(2),o[0],0,0,0), C1,0); \
    KRD(GL,3); GAPB(o[1]=__builtin_amdgcn_mfma_f32_32x32x16_bf16(PAF(2),VFR(6),o[1],0,0,0), C1,4); \
    BLD(GL,BL1(P1,(t)+1,0);BL1(P1,(t)+1,1)); GAPB(o[0]=__builtin_amdgcn_mfma_f32_32x32x16_bf16(PAF(3),VFR(3),o[0],0,0,0), C1,8); \
    BLD(GL,BL1(P1,(t)+1,2);BL1(P1,(t)+1,3)); GAPB(o[1]=__builtin_amdgcn_mfma_f32_32x32x16_bf16(PAF(3),VFR(7),o[1],0,0,0), C1,12); \
    }while(0)
  int t=1;
  #undef CMASK
  #define CMASK(P0,P1,t) do{}while(0)
  for(;t+5<NT;t+=2){
    STEP(pB0,pB1,pA0,pA1,t,true,true,true);     WAIT_BAR(2); RESC(); ROT();
    STEP(pA0,pA1,pB0,pB1,t+1,true,true,true);   WAIT_BAR(2); RESC(); ROT();
  }
  #undef CMASK
  #define CMASK(P0,P1,t) do{ if(MODE==1){ swamask(P0,P1,(T0+(t))*KVBLK-q0,qrel,hi); } else { int jb_=(t)-(NT-4); if(jb_>=0)cmask(P0,P1,jb_,qrel,hi); } }while(0)
  #define ENDW(tt) do{ if((tt)+3<NT){WAIT_BAR(2);} else if((tt)+2<NT){WAIT_BAR(1);} else {WAIT_BAR(0);} }while(0)
  for(;t+1<NT;t+=2){
    STEP(pB0,pB1,pA0,pA1,t,(t+3<NT),(t+1<NT),(t+1<NT));       ENDW(t);   RESC(); ROT();
    STEP(pA0,pA1,pB0,pB1,t+1,(t+4<NT),(t+2<NT),(t+2<NT));     ENDW(t+1); RESC(); ROT();
  }
  STEP(pB0,pB1,pA0,pA1,NT-1,false,false,false); RESC();
  { float sacc=pB0[0]+pB0[1]; _Pragma("unroll") for(int r=2;r<16;++r)sacc+=pB0[r]; _Pragma("unroll") for(int r=0;r<16;++r)sacc+=pB1[r]; l_reg+=sacc;
    pw0=(u32x4){PKW(pB0,0),PKW(pB0,2),PKW(pB0,4),PKW(pB0,6)};pw1=(u32x4){PKW(pB0,8),PKW(pB0,10),PKW(pB0,12),PKW(pB0,14)};pw2=(u32x4){PKW(pB1,0),PKW(pB1,2),PKW(pB1,4),PKW(pB1,6)};pw3=(u32x4){PKW(pB1,8),PKW(pB1,10),PKW(pB1,12),PKW(pB1,14)};
    SBAR(); pv(o,vb0+sl_cur,PAF(0),PAF(1),PAF(2),PAF(3)); }
  #undef PKW
  #undef PAF
  #undef VFR
  #undef PIN
  #undef MX3
  #undef GAPA
  #undef GAPB
  #undef EX
  #undef VRD
  #undef KRD
  #undef BLD
  #undef STEP
  #undef ENDW
  {auto rr=__builtin_amdgcn_permlane32_swap(__float_as_uint(l_reg),__float_as_uint(l_reg),false,false);l_reg=__uint_as_float(rr[0])+__uint_as_float(rr[1]);}
  if(MODE==1)l_reg+=__builtin_amdgcn_exp2f(sinkc-mhat);
  if(hi==0)wsf[32+r32]=l_reg;asm volatile("s_waitcnt lgkmcnt(0)":::"memory");
  float rli[16];
  #pragma unroll
  for(int r=0;r<16;++r)rli[r]=__builtin_amdgcn_rcpf(wsf[32+crow(r,hi)]);
  bf16*Ow=Oh+(long)(q0+wid*QBLK)*OP;
  { bf16*stg=(bf16*)(shm+LDS_OST)+wid*2048;
    #pragma unroll
    for(int r=0;r<16;++r){const int orow=crow(r,hi);
      #pragma unroll
      for(int d0=0;d0<2;++d0)stg[orow*64+d0*32+r32]=__float2bfloat16(o[d0][r]*rli[r]);}
    asm volatile("s_waitcnt lgkmcnt(0)":::"memory");
    #pragma unroll
    for(int i=0;i<4;++i){const int row=i*8+(lane>>3),ch=lane&7; const u32x4 v=*(const u32x4*)(stg+row*64+ch*8); ATTN_STORE16(Ow+(long)row*OP+ch*8,v);} }
  asm volatile("s_waitcnt lgkmcnt(0)\n\ts_barrier":::"memory");
  #undef DMA_K
  #undef DMA_V
  #undef CMASK
  #undef BL0
  #undef BL1
  #undef BLALL
  #undef SUBM
  #undef START
  #undef RESC
  #undef ROT
}
constexpr int ATTN_LDS_BYTES=LDS_BYTES;
struct AttnArgs { const bf16* proj; bf16* obuf; const float* bias; const float* knt; const float* sinks; unsigned* queue; };
template<int THRL=8> __device__ __forceinline__ void attn_phase(char*lds,const AttnArgs&T,int vcu,int G){
  for(int j=vcu;j<1024;j+=G){
    const int v=j&255,i=j>>8,bh=v>>3,s=v&7,b=bh>>4,h=bh&15; const long rb=(long)b*SEQ; const int qb=4*s+i;
    const float slope2=exp2f(-0.5f*(float)(h+1))*1.4426950408889634f, sink2=T.sinks[h]*1.4426950408889634f;
    attn_unit<1,THRL>(qb,T.proj+rb*PP+h*D,T.proj+rb*PP+1024+(h>>2)*D,T.proj+rb*PP+1280+(h>>2)*D,T.obuf+rb*OP+h*D,nullptr,nullptr,slope2,sink2,lds);
  }
  __attribute__((address_space(3))) int*qw=(__attribute__((address_space(3))) int*)((lds_cptr)lds+LDS_MISC)+20;
  for(;;){
    if(threadIdx.x==0)*qw=(int)__hip_atomic_fetch_add(T.queue,1u,__ATOMIC_RELAXED,__HIP_MEMORY_SCOPE_AGENT);
    __syncthreads();
    const int j=__builtin_amdgcn_readfirstlane(*qw);
    if(j>=1024)break;
    const int qb=31-(j>>5),bh=j&31,b=bh>>4,h=bh&15; const long rb=(long)b*SEQ;
    attn_unit<0,THRL>(qb,T.proj+rb*PP+1536+h*D,T.proj+rb*PP+2560+h*D,T.proj+rb*PP+3584+h*D,T.obuf+rb*OP+1024+h*D,T.bias+(long)bh*SEQ,T.knt+bh*(SEQ/KVBLK),0.f,0.f,lds);
  }
}
#undef SBAR
#undef WAIT_BAR
}

constexpr int NWAVES = 8;
#ifndef MK_N_LAUNCHES
#define MK_N_LAUNCHES 1
#endif
constexpr int PER_PHASE = 11;
constexpr int N_LAUNCHES = MK_N_LAUNCHES;
constexpr int BATCH = 2, SEQ = 8192, DM = 2048, M = BATCH * SEQ;
constexpr int NPROJ = 4864, PROJ_P = 4608, NCOLS_IN = 4624;
constexpr int NEXP = 32, DEXP = 512, LIST_CAP = pg8::LIST_CAP;
constexpr float EPS = 1e-6f;
constexpr float WSCALE_GU = 32.0f, WSCALE_DN = 16.0f;
constexpr size_t MiB = 1u << 20;
constexpr size_t WS_CTL = 0, CTL_ZERO_BYTES = 1 * MiB;
constexpr size_t WS_MOD = 1 * MiB;
constexpr size_t WS_LOGF = 2 * MiB;
constexpr size_t WS_BIAS = 3 * MiB;
constexpr size_t WS_LOGITS = 4 * MiB;
constexpr size_t WS_SLOT = 8 * MiB;
constexpr size_t WS_EW = 8 * MiB + 512 * 1024;
constexpr size_t WS_KNT = 8 * MiB + 768 * 1024;
constexpr size_t WS_LIST = 9 * MiB;
constexpr size_t WS_WR = 12 * MiB;
constexpr size_t WS_WIN = 13 * MiB;
constexpr size_t WS_WOUT = 32 * MiB;
constexpr size_t WS_WGU = 40 * MiB;
constexpr size_t WS_XN8 = 104 * MiB;
constexpr size_t WS_WDN = 168 * MiB;
constexpr size_t WS_XN = 232 * MiB;
constexpr size_t WS_PROJ = 296 * MiB;
constexpr size_t WS_OBUF = 440 * MiB;
constexpr size_t WS_HID = 504 * MiB;
constexpr size_t WS_YS = WS_PROJ;
constexpr size_t WS_END = 544 * MiB;
static_assert(WS_YS + (size_t)40960 * 2048 * 2 <= WS_HID && WS_HID + (size_t)40960 * 512 * 2 <= WS_END, "d_ws map");
constexpr int CW_TMO = 0, CW_CODE = 1, CW_BAR = 4096, CW_CNT = 8192, CW_QUEUE = 8320;
constexpr int RING_OFF = 0, RING_BYTES = 131072;
constexpr int LDSCTL_OFF = RING_BYTES, MISC_OFF = LDSCTL_OFF + 320;
constexpr int LDS_BYTES = 147456;
static_assert(attn_body::ATTN_LDS_BYTES <= RING_BYTES && pg8::STAGE_BYTES <= RING_BYTES, "phase scratch fits the ring region");
#define GAS __attribute__((address_space(1)))
#define LAS __attribute__((address_space(3)))
typedef unsigned short bf16;
typedef unsigned v4u __attribute__((ext_vector_type(4)));
typedef float f32x4 __attribute__((ext_vector_type(4)));
typedef short bf16x8 __attribute__((ext_vector_type(8)));
typedef GAS unsigned gu32;
typedef GAS unsigned long long gu64;
#define RLX_AGENT __ATOMIC_RELAXED, __HIP_MEMORY_SCOPE_AGENT
#define LDS_WAIT() asm volatile("s_waitcnt lgkmcnt(0)" ::: "memory")
#define VM_WAIT() asm volatile("s_waitcnt vmcnt(0)" ::: "memory")
__device__ __forceinline__ unsigned long long rt() { return __builtin_amdgcn_s_memrealtime(); }
__device__ __forceinline__ unsigned f2bf(float f) { unsigned u = __builtin_bit_cast(unsigned, f); return (u + 0x7fffu + ((u >> 16) & 1u)) >> 16; }
__device__ __forceinline__ unsigned pk2(float lo, float hi) { return f2bf(lo) | (f2bf(hi) << 16); }

#define XB_TMO      128
#define XB_XCNT(j)  (256  + 64 * (j))
#define XB_XSUB(j)  (1280 + 64 * (j))
#define XB_XGEN(j)  (2304 + 64 * (j))
#define XB_TOP      3328
#define XB_TOPGEN   3392
#define XCD_BAR_WORDS 3456
#define XB_SPIN_CAP (1u << 18)

__device__ __forceinline__ unsigned xb_ld(unsigned* p)              { return __hip_atomic_load(p, __ATOMIC_RELAXED, __HIP_MEMORY_SCOPE_AGENT); }
__device__ __forceinline__ unsigned xb_add(unsigned* p, unsigned v) { return __hip_atomic_fetch_add(p, v, __ATOMIC_RELAXED, __HIP_MEMORY_SCOPE_AGENT); }
__device__ __forceinline__ unsigned xb_xcc_id() { return (unsigned)__builtin_amdgcn_s_getreg((3 << 11) | 20) & 0xFu; }
#define XB_SPIN(cond, bar) do { unsigned _sp = 0; while (cond) { __builtin_amdgcn_s_sleep(1); \
    if ((++_sp & 255u) == 0u) { if (xb_ld(&(bar)[XB_TMO])) break; if (_sp > XB_SPIN_CAP) { atomicAdd(&(bar)[XB_TMO], 1u); break; } } } } while (0)

struct XcdBarrier {
    unsigned* bar; unsigned x;
    volatile LAS unsigned* st;
};

__device__ __forceinline__ XcdBarrier xcd_barrier_post(unsigned* bar, volatile LAS unsigned* st) {
    XcdBarrier b; b.bar = bar; b.x = xb_xcc_id(); b.st = st;
    if (threadIdx.x == 0) (void)xb_add(&bar[XB_XCNT(b.x)], 1u);
    return b;
}
__device__ __forceinline__ void xcd_barrier_complete(unsigned* bar, unsigned x, unsigned& nloc, unsigned& nx) {
    const unsigned G = gridDim.x * gridDim.y * gridDim.z;
    unsigned sum, cnt, mine, sp = 0u;
    for (;;) {
        sum = 0u; cnt = 0u; mine = 0u;
#pragma unroll
        for (unsigned j = 0; j < 16; ++j) { const unsigned c = xb_ld(&bar[XB_XCNT(j)]); sum += c; cnt += (c > 0u) ? 1u : 0u; mine = (j == x) ? c : mine; }
        if (sum == G) break;
        __builtin_amdgcn_s_sleep(1);
        if ((++sp & 255u) == 0u) { if (xb_ld(&bar[XB_TMO])) break; if (sp > XB_SPIN_CAP) { atomicAdd(&bar[XB_TMO], 1u); break; } }
    }
    nloc = mine > 0u ? mine : 1u; nx = cnt > 0u ? cnt : 1u;
}

__device__ __forceinline__ void xcd_barrier(const XcdBarrier& b) {
    asm volatile("s_waitcnt vmcnt(0)" ::: "memory");
    __syncthreads();
    if (threadIdx.x == 0) {
        unsigned* bar = b.bar;
        __builtin_amdgcn_s_waitcnt(0);
        unsigned nloc = b.st[0], nx = b.st[1];
        if (nloc == 0u) { xcd_barrier_complete(bar, b.x, nloc, nx); b.st[0] = nloc; b.st[1] = nx; }
        const unsigned old = xb_add(&bar[XB_XSUB(b.x)], 1u);
        const unsigned gen = old / nloc;
        if (old + 1u == (gen + 1u) * nloc) {
            __builtin_amdgcn_fence(__ATOMIC_RELEASE, "agent");
            asm volatile("s_waitcnt vmcnt(0)" ::: "memory");
            const unsigned og = xb_add(&bar[XB_TOP], 1u);
            const unsigned tg = og / nx;
            if (og + 1u == (tg + 1u) * nx) xb_add(&bar[XB_TOPGEN], 1u);
            else XB_SPIN(xb_ld(&bar[XB_TOPGEN]) == tg, bar);
            __builtin_amdgcn_fence(__ATOMIC_ACQUIRE, "agent");
            xb_add(&bar[XB_XGEN(b.x)], 1u);
            asm volatile("s_waitcnt vmcnt(0)" ::: "memory");
        } else {
            XB_SPIN(xb_ld(&bar[XB_XGEN(b.x)]) == gen, bar);
            __builtin_amdgcn_fence(__ATOMIC_ACQUIRE, "agent");
            asm volatile("s_waitcnt vmcnt(0)" ::: "memory");
        }
    }
    __syncthreads();
}

__device__ __forceinline__ float wave_sum(float v) {
#pragma unroll
    for (int o = 1; o < 64; o <<= 1) v += __shfl_xor(v, o);
    return v;
}
__device__ __forceinline__ void p0_mod_item(LAS unsigned char* lds, const float* c, const float* w_ada, const float* b_ada, float* mod, int item, int tid) {
    LAS float* sc = (LAS float*)lds; LAS float* red = (LAS float*)(lds + 16384);
    for (int i = tid; i < 2 * DM; i += NWAVES * 64) { const float v = c[i]; sc[i] = v / (1.0f + expf(-v)); }
    __syncthreads();
    const int cg = tid & 15, rg = tid >> 4, n0 = item * 64;
    f32x4 a0 = {0.f, 0.f, 0.f, 0.f}, a1 = {0.f, 0.f, 0.f, 0.f};
    const float* wp = w_ada + (size_t)rg * (6 * DM) + n0 + 4 * cg;
#pragma unroll 8
    for (int k = rg; k < DM; k += 32) { const f32x4 w = *(const f32x4*)wp; wp += (size_t)32 * (6 * DM); a0 += sc[k] * w; a1 += sc[DM + k] * w; }
    *(LAS f32x4*)(red + (rg * 2 + 0) * 64 + 4 * cg) = a0; *(LAS f32x4*)(red + (rg * 2 + 1) * 64 + 4 * cg) = a1;
    __syncthreads();
    if (tid < 128) { const int b = tid >> 6, col = tid & 63; float s = 0.f;
#pragma unroll 8
        for (int r = 0; r < 32; ++r) s += red[(r * 2 + b) * 64 + col];
        mod[b * (6 * DM) + n0 + col] = s + b_ada[n0 + col]; }
    __syncthreads();
}
__device__ __forceinline__ void tr_item(const float* W, int Nsrc, int k0, int n0, bf16* dst, int Kd, LAS float* scr, int lane) {
    const int n = n0 + (lane & 31);
#pragma unroll 8
    for (int i = 0; i < 32; ++i) { const int kk = 2 * i + (lane >> 5); float v = 0.f; if (n < Nsrc) v = W[(size_t)(k0 + kk) * Nsrc + n]; scr[kk * 33 + (lane & 31)] = v; }
    LDS_WAIT(); asm volatile("" ::: "memory");
    const int c = lane & 7;
#pragma unroll
    for (int j = 0; j < 4; ++j) { const int nn = (lane >> 3) + 8 * j; const LAS float* s = scr + (8 * c) * 33 + nn;
        v4u o; o.x = pk2(s[0 * 33], s[1 * 33]); o.y = pk2(s[2 * 33], s[3 * 33]); o.z = pk2(s[4 * 33], s[5 * 33]); o.w = pk2(s[6 * 33], s[7 * 33]);
        *(GAS v4u*)(dst + (size_t)nn * Kd + k0 + 8 * c) = o; }
    LDS_WAIT(); asm volatile("" ::: "memory");
}
__device__ __forceinline__ void tr_item8(const float* W, int Nsrc, int k0, int n0, unsigned char* dst, int Kd, float scale, LAS float* scr, int lane) {
    const int n = n0 + (lane & 31);
#pragma unroll 8
    for (int i = 0; i < 32; ++i) { const int kk = 2 * i + (lane >> 5); float v = 0.f; if (n < Nsrc) v = W[(size_t)(k0 + kk) * Nsrc + n]; scr[kk * 33 + (lane & 31)] = v * scale; }
    LDS_WAIT(); asm volatile("" ::: "memory");
    const int c = lane & 3;
#pragma unroll
    for (int j = 0; j < 2; ++j) { const int nn = (lane >> 2) + 16 * j; const LAS float* s = scr + (16 * c) * 33 + nn;
        v4u o; o.x = pg8::pk4_fp8(s[0 * 33], s[1 * 33], s[2 * 33], s[3 * 33]); o.y = pg8::pk4_fp8(s[4 * 33], s[5 * 33], s[6 * 33], s[7 * 33]);
        o.z = pg8::pk4_fp8(s[8 * 33], s[9 * 33], s[10 * 33], s[11 * 33]); o.w = pg8::pk4_fp8(s[12 * 33], s[13 * 33], s[14 * 33], s[15 * 33]);
        *(GAS v4u*)(dst + (size_t)nn * Kd + k0 + 16 * c) = o; }
    LDS_WAIT(); asm volatile("" ::: "memory");
}
__device__ __forceinline__ void norm_mod_rows(const float* X, const float* g, const float* mod, int ish, int isc, bf16* OUT, int gw, int NGW, int lane) {
    int curb = -1; f32x4 ca[8], cb[8];
    for (int m = gw; m < M; m += NGW) {
        const int b = m >= SEQ ? 1 : 0;
        if (b != curb) { curb = b;
#pragma unroll
            for (int j = 0; j < 8; ++j) { const int col = 4 * lane + 256 * j; const f32x4 gv = *(const f32x4*)(g + col), sv = *(const f32x4*)(mod + b * (6 * DM) + isc * DM + col);
                ca[j] = gv * (sv + 1.0f); cb[j] = *(const f32x4*)(mod + b * (6 * DM) + ish * DM + col); } }
        const GAS f32x4* xr = (const GAS f32x4*)(X + (size_t)m * DM) + lane;
        f32x4 v[8]; float s = 0.f;
#pragma unroll
        for (int j = 0; j < 8; ++j) { v[j] = xr[64 * j]; s += (v[j].x * v[j].x + v[j].y * v[j].y) + (v[j].z * v[j].z + v[j].w * v[j].w); }
        const float rstd = 1.0f / sqrtf(wave_sum(s) * (1.0f / DM) + EPS);
        GAS unsigned long long* o8 = (GAS unsigned long long*)(OUT + (size_t)m * DM) + lane;
#pragma unroll
        for (int j = 0; j < 8; ++j) { const f32x4 h = v[j] * rstd * ca[j] + cb[j]; o8[64 * j] = (unsigned long long)pk2(h.x, h.y) | ((unsigned long long)pk2(h.z, h.w) << 32); }
    }
}
__device__ __forceinline__ float bf_lo(unsigned w) { return __builtin_bit_cast(float, w << 16); }
__device__ __forceinline__ float bf_hi(unsigned w) { return __builtin_bit_cast(float, w & 0xffff0000u); }
__device__ __forceinline__ void onorm_rows(bf16* O, const float* ga, const float* gb, int gw, int NGW, int lane) {
    f32x4 gg[4][2];
#pragma unroll
    for (int j = 0; j < 4; ++j) { const float* gp = (j < 2 ? ga + 512 * j : gb + 512 * (j - 2)) + 8 * lane; gg[j][0] = *(const f32x4*)gp; gg[j][1] = *(const f32x4*)(gp + 4); }
    for (int m = gw; m < M; m += NGW) {
        GAS v4u* row = (GAS v4u*)(O + (size_t)m * DM) + lane; v4u w[4]; float ss[4];
#pragma unroll
        for (int j = 0; j < 4; ++j) { w[j] = row[64 * j]; float s = 0.f;
#pragma unroll
            for (int q = 0; q < 4; ++q) { const float a = bf_lo(w[j][q]), b = bf_hi(w[j][q]); s += a * a + b * b; } ss[j] = s; }
        const float ra = 1.0f / sqrtf(wave_sum(ss[0] + ss[1]) * (1.0f / 1024.0f) + EPS), rb = 1.0f / sqrtf(wave_sum(ss[2] + ss[3]) * (1.0f / 1024.0f) + EPS);
#pragma unroll
        for (int j = 0; j < 4; ++j) { const float r = j < 2 ? ra : rb; v4u o;
#pragma unroll
            for (int q = 0; q < 4; ++q) { const float g0 = gg[j][q >> 1][(q & 1) * 2], g1 = gg[j][q >> 1][(q & 1) * 2 + 1]; o[q] = pk2(bf_lo(w[j][q]) * r * g0, bf_hi(w[j][q]) * r * g1); }
            row[64 * j] = o; }
    }
}
__device__ __forceinline__ void scan_seq(LAS unsigned char* lds, const float* logf, float* bias, int bh, int tid) {
    LAS float* wt = (LAS float*)lds; const int b = bh >> 4, h = bh & 15, lane = tid & 63, w = tid >> 6;
    const float* src = logf + ((size_t)b * SEQ + 16 * tid) * 16 + h; float v[16]; float tot = 0.f;
#pragma unroll
    for (int i = 0; i < 16; ++i) { tot += src[i * 16]; v[i] = tot; }
    float inc = tot;
#pragma unroll
    for (int o = 1; o < 64; o <<= 1) { const float t = __shfl_up(inc, o); if (lane >= o) inc += t; }
    if (lane == 63) wt[w] = inc;
    __syncthreads();
    float base = 0.f;
#pragma unroll
    for (int q = 0; q < NWAVES; ++q) { const float t = wt[q]; if (q < w) base += t; }
    const float off = base + (inc - tot); float* dst = bias + (size_t)bh * SEQ + 16 * tid;
#pragma unroll
    for (int i = 0; i < 16; i += 4) { f32x4 o; o[0] = -1.4426950408889634f * (off + v[i]); o[1] = -1.4426950408889634f * (off + v[i + 1]); o[2] = -1.4426950408889634f * (off + v[i + 2]); o[3] = -1.4426950408889634f * (off + v[i + 3]); *(f32x4*)(dst + i) = o; }
    __syncthreads();
}
__device__ __forceinline__ void knt_tiles(const bf16* proj, float* knt, int gw, int NGW, int lane) {
    for (int it = gw; it < 32 * (SEQ / 64); it += NGW) {
        const int bh = it >> 7, t = it & 127, b = bh >> 4, h = bh & 15;
        const GAS v4u* kr = (const GAS v4u*)(proj + ((size_t)b * SEQ + 64 * t + lane) * PROJ_P + 2560 + h * 64); float s = 0.f;
#pragma unroll
        for (int j = 0; j < 8; ++j) { const v4u w = kr[j];
#pragma unroll
            for (int q = 0; q < 4; ++q) { const float a = bf_lo(w[q]), c = bf_hi(w[q]); s += a * a + c * c; } }
        float n = sqrtf(s);
#pragma unroll
        for (int o = 1; o < 64; o <<= 1) n = fmaxf(n, __shfl_xor(n, o));
        if (lane == 0) knt[it] = n;
    }
}
__device__ __forceinline__ void route_decide(const LAS float* lr, const float* b_group, const float* b_expert, int& e1, int& e2, float& w1, float& w2) {
    float gl[4]; int gs = 0; float gmax;
#pragma unroll
    for (int j = 0; j < 4; ++j) gl[j] = lr[j] + b_group[j];
    gmax = gl[0];
#pragma unroll
    for (int j = 1; j < 4; ++j) if (gl[j] > gmax) { gmax = gl[j]; gs = j; }
    float den = 0.f;
#pragma unroll
    for (int j = 0; j < 4; ++j) den += expf(gl[j] - gmax);
    const float gval = 1.0f / den;
    float el[8];
#pragma unroll
    for (int j = 0; j < 8; ++j) el[j] = lr[4 + 8 * gs + j] + b_expert[8 * gs + j];
    int i1 = 0; float v1 = el[0];
#pragma unroll
    for (int j = 1; j < 8; ++j) if (el[j] > v1) { v1 = el[j]; i1 = j; }
    int i2 = -1; float v2 = -INFINITY;
#pragma unroll
    for (int j = 0; j < 8; ++j) if (j != i1 && el[j] > v2) { v2 = el[j]; i2 = j; }
    const float t = expf(v2 - v1); w1 = gval / (1.0f + t); w2 = gval * t / (1.0f + t);
    e1 = 8 * gs + i1; e2 = 8 * gs + i2;
}
constexpr int NR_PITCH = 2056;
constexpr int NR_A = 0, NR_RED = 16 * NR_PITCH * 2, NR_LOGIT = NR_RED + 8 * 3 * 64 * 16, NR_TOK = NR_LOGIT + 16 * 40 * 4, NR_CNT = NR_TOK + 4 * 64 * 4, NR_COEF = NR_CNT + 256, NR_END = NR_COEF + 2 * DM * 4;
static_assert(NR_END <= RING_BYTES, "norm+route scratch fits the ring region");
__device__ __forceinline__ void norm_route_phase(LAS unsigned char* lds, const float* X, const float* g, const float* mod, unsigned char* XN8, const bf16* WR, const float* b_group, const float* b_expert,
                                                 gu32* gcnt, int* list, int* slot, float* ew, int bx, int G, int tid) {
    typedef short bf16x8v __attribute__((ext_vector_type(8)));
    const int lane = tid & 63, wave = __builtin_amdgcn_readfirstlane(tid >> 6), fr = lane & 15, fq = lane >> 4;
    LAS float* red = (LAS float*)(lds + NR_RED); LAS float* logit = (LAS float*)(lds + NR_LOGIT);
    LAS int* te1 = (LAS int*)(lds + NR_TOK); LAS int* te2 = te1 + 64; LAS float* tw1 = (LAS float*)(te2 + 64); LAS float* tw2 = tw1 + 64;
    LAS int* lcnt = (LAS int*)(lds + NR_CNT); LAS int* gbase = lcnt + 32;
    bf16x8v bfr[3][8];
#pragma unroll
    for (int j = 0; j < 3; ++j)
#pragma unroll
        for (int s = 0; s < 8; ++s) bfr[j][s] = *(const bf16x8v*)(WR + (size_t)(16 * j + fr) * DM + 256 * wave + 32 * s + 8 * fq);
    int curb = -1; f32x4 v[2][8]; LAS f32x4* coefA = (LAS f32x4*)(lds + NR_COEF); LAS f32x4* coefB = coefA + DM / 4;
#define NR_BAR() asm volatile("s_waitcnt lgkmcnt(0)\n\ts_barrier" ::: "memory")
#define NR_LOAD(blk_, it_) do { _Pragma("unroll") for (int rr = 0; rr < 2; ++rr) { const GAS f32x4* xr = (const GAS f32x4*)(X + (size_t)((blk_) * 64 + 16 * (it_) + 2 * wave + rr) * DM) + lane; \
        _Pragma("unroll") for (int j = 0; j < 8; ++j) v[rr][j] = xr[64 * j]; } } while (0)
    int blk = bx, it = 0;
    if (blk < M / 64) NR_LOAD(blk, 0);
    while (blk < M / 64) {
        const int tok0 = blk * 64, b = tok0 >= SEQ ? 1 : 0;
        if (b != curb) { curb = b;
            { const int col = 4 * tid; const f32x4 gv = *(const f32x4*)(g + col), sv = *(const f32x4*)(mod + b * (6 * DM) + 4 * DM + col); coefA[tid] = gv * (sv + 1.0f); coefB[tid] = *(const f32x4*)(mod + b * (6 * DM) + 3 * DM + col); }
            NR_BAR(); }
        if (it == 0 && tid < 32) lcnt[tid] = 0;
#pragma unroll
        for (int rr = 0; rr < 2; ++rr) {
            const int r = 2 * wave + rr, m = tok0 + 16 * it + r; float s = 0.f;
#pragma unroll
            for (int j = 0; j < 8; ++j) s += (v[rr][j].x * v[rr][j].x + v[rr][j].y * v[rr][j].y) + (v[rr][j].z * v[rr][j].z + v[rr][j].w * v[rr][j].w);
            const float rstd = 1.0f / sqrtf(wave_sum(s) * (1.0f / DM) + EPS);
            GAS unsigned* o4 = (GAS unsigned*)(XN8 + (size_t)m * DM) + lane;
            LAS unsigned long long* l8 = (LAS unsigned long long*)(lds + NR_A + r * (NR_PITCH * 2)) + lane;
#pragma unroll
            for (int j = 0; j < 8; ++j) { const f32x4 h = v[rr][j] * rstd * coefA[lane + 64 * j] + coefB[lane + 64 * j]; const unsigned long long w = (unsigned long long)pk2(h.x, h.y) | ((unsigned long long)pk2(h.z, h.w) << 32); o4[64 * j] = pg8::pk4_fp8(h.x, h.y, h.z, h.w); l8[64 * j] = w; }
        }
        int nit = it + 1, nblk = blk; if (nit == 4) { nit = 0; nblk += G; }
        if (nblk < M / 64) NR_LOAD(nblk, nit);
        NR_BAR();
        f32x4 acc[3] = {{0.f, 0.f, 0.f, 0.f}, {0.f, 0.f, 0.f, 0.f}, {0.f, 0.f, 0.f, 0.f}};
#pragma unroll
        for (int s = 0; s < 8; ++s) { const bf16x8v a = *(const LAS bf16x8v*)(lds + NR_A + fr * (NR_PITCH * 2) + (256 * wave + 32 * s + 8 * fq) * 2);
#pragma unroll
            for (int j = 0; j < 3; ++j) acc[j] = __builtin_amdgcn_mfma_f32_16x16x32_bf16(a, bfr[j][s], acc[j], 0, 0, 0); }
#pragma unroll
        for (int j = 0; j < 3; ++j) *(LAS f32x4*)(red + ((wave * 3 + j) * 64 + lane) * 4) = acc[j];
        NR_BAR();
        for (int o = tid; o < 16 * 36; o += NWAVES * 64) { const int t = o / 36, c = o % 36, j = c >> 4, n = c & 15, sl = (t >> 2) * 16 + n; float s = 0.f;
#pragma unroll
            for (int w = 0; w < NWAVES; ++w) s += red[((w * 3 + j) * 64 + sl) * 4 + (t & 3)];
            logit[t * 40 + c] = s; }
        NR_BAR();
        if (tid < 16) { int e1, e2; float w1, w2; route_decide(logit + tid * 40, b_group, b_expert, e1, e2, w1, w2); const int k = 16 * it + tid; te1[k] = e1; te2[k] = e2; tw1[k] = w1; tw2[k] = w2; }
        if (it == 3) {
            NR_BAR();
            int e1 = 0, e2 = 0, p1 = 0, p2 = 0;
            if (tid < 64) { e1 = te1[tid]; e2 = te2[tid];
                p1 = __hip_atomic_fetch_add(&lcnt[e1], 1, __ATOMIC_RELAXED, __HIP_MEMORY_SCOPE_WORKGROUP); p2 = __hip_atomic_fetch_add(&lcnt[e2], 1, __ATOMIC_RELAXED, __HIP_MEMORY_SCOPE_WORKGROUP); }
            NR_BAR();
            if (tid < 32) { const int n = lcnt[tid]; gbase[tid] = n ? (int)__hip_atomic_fetch_add(gcnt + tid, (unsigned)n, RLX_AGENT) : 0; }
            NR_BAR();
            if (tid < 64) { const int tok = tok0 + tid; p1 += gbase[e1]; p2 += gbase[e2];
                list[(size_t)e1 * LIST_CAP + p1] = tok; list[(size_t)e2 * LIST_CAP + p2] = tok;
                slot[2 * tok] = (e1 << 16) | p1; slot[2 * tok + 1] = (e2 << 16) | p2; ew[2 * tok] = tw1[tid]; ew[2 * tok + 1] = tw2[tid]; }
            NR_BAR();
        }
        blk = nblk; it = nit;
    }
#undef NR_BAR
#undef NR_LOAD
}
__device__ __forceinline__ void moe_tables(LAS unsigned char* ldsctl, gu32* gcnt, int tid) {
    LAS int* pfx = (LAS int*)ldsctl; LAS int* cnt = (LAS int*)(ldsctl + 160);
    if (tid < 32) cnt[tid] = (int)__hip_atomic_load(gcnt + tid, RLX_AGENT);
    __syncthreads();
    if (tid == 0) { int a = 0; for (int e = 0; e < 32; ++e) { pfx[e] = a; a += (cnt[e] + 255) >> 8; } pfx[32] = a; }
    __syncthreads();
}
__device__ __forceinline__ void final_rows(float* out, const bf16* YS, const int* slot, const float* ew, const float* mod, const float* fg, const LAS int* pfx, int gw, int NGW, int lane) {
    int curb = -1; f32x4 gm[4][2], gf[4][2];
#pragma unroll
    for (int j = 0; j < 4; ++j) { gf[j][0] = *(const f32x4*)(fg + 8 * lane + 512 * j); gf[j][1] = *(const f32x4*)(fg + 8 * lane + 512 * j + 4); }
    for (int m = gw; m < M; m += NGW) {
        const int b = m >= SEQ ? 1 : 0;
        if (b != curb) { curb = b;
#pragma unroll
            for (int j = 0; j < 4; ++j) { const float* p = mod + b * (6 * DM) + 5 * DM + 8 * lane + 512 * j; gm[j][0] = *(const f32x4*)p; gm[j][1] = *(const f32x4*)(p + 4); } }
        const int s0 = slot[2 * m], s1 = slot[2 * m + 1]; const float w0 = ew[2 * m], w1 = ew[2 * m + 1];
        const size_t r0 = (size_t)(pfx[s0 >> 16] * 256 + (s0 & 0xffff)), r1 = (size_t)(pfx[s1 >> 16] * 256 + (s1 & 0xffff));
        const GAS v4u* y0 = (const GAS v4u*)(YS + r0 * DM) + lane; const GAS v4u* y1 = (const GAS v4u*)(YS + r1 * DM) + lane;
        GAS f32x4* xr = (GAS f32x4*)(out + (size_t)m * DM) + 2 * lane;
        f32x4 v[4][2]; float s = 0.f;
#pragma unroll
        for (int j = 0; j < 4; ++j) { const v4u a = y0[64 * j], c = y1[64 * j]; const f32x4 x0 = xr[128 * j], x1 = xr[128 * j + 1];
            f32x4 ya, yb; ya[0] = w0 * bf_lo(a[0]) + w1 * bf_lo(c[0]); ya[1] = w0 * bf_hi(a[0]) + w1 * bf_hi(c[0]); ya[2] = w0 * bf_lo(a[1]) + w1 * bf_lo(c[1]); ya[3] = w0 * bf_hi(a[1]) + w1 * bf_hi(c[1]);
            yb[0] = w0 * bf_lo(a[2]) + w1 * bf_lo(c[2]); yb[1] = w0 * bf_hi(a[2]) + w1 * bf_hi(c[2]); yb[2] = w0 * bf_lo(a[3]) + w1 * bf_lo(c[3]); yb[3] = w0 * bf_hi(a[3]) + w1 * bf_hi(c[3]);
            v[j][0] = x0 + gm[j][0] * ya; v[j][1] = x1 + gm[j][1] * yb;
#pragma unroll
            for (int q = 0; q < 2; ++q) s += (v[j][q].x * v[j][q].x + v[j][q].y * v[j][q].y) + (v[j][q].z * v[j][q].z + v[j][q].w * v[j][q].w); }
        const float rstd = 1.0f / sqrtf(wave_sum(s) * (1.0f / DM) + EPS);
#pragma unroll
        for (int j = 0; j < 4; ++j) { xr[128 * j] = v[j][0] * rstd * gf[j][0]; xr[128 * j + 1] = v[j][1] * rstd * gf[j][1]; }
    }
}

struct Args { const float* in[20]; float* out; unsigned char* ws; int ph_lo, ph_hi, li, pad; };
__global__ void __launch_bounds__(NWAVES * 64, 2) fwd_kernel(Args args) {
    extern __shared__ __attribute__((aligned(16))) unsigned char lds_raw[];
    LAS unsigned char* lds = (LAS unsigned char*)lds_raw;
    volatile LAS unsigned* MISC = (volatile LAS unsigned*)(lds + MISC_OFF);
    const int tid = threadIdx.x, lane = tid & 63, wave = __builtin_amdgcn_readfirstlane(tid >> 6);
    const int G = gridDim.x; const int bx = blockIdx.x; const int vcu = (G % 8 == 0) ? (bx % 8) * (G / 8) + bx / 8 : bx;
    const int gw = vcu * NWAVES + wave, NGW = G * NWAVES;
    typedef const __attribute__((address_space(4))) Args* kargp_t;
#define KP() ({ kargp_t kp_ = (kargp_t)__builtin_amdgcn_kernarg_segment_ptr(); asm volatile("" : "+s"(kp_)); kp_; })
#define WSP(kp, off) (kp->ws + (off))
    gu32* ctl = (gu32*)(args.ws + WS_CTL);
    for (int u = tid; u < (LDS_BYTES - LDSCTL_OFF) / 4; u += NWAVES * 64) ((LAS unsigned*)(lds + LDSCTL_OFF))[u] = 0u;
    __syncthreads();
    XcdBarrier bar; bar.bar = (unsigned*)(ctl + CW_BAR) + args.li * 12288; bar.x = 0; bar.st = nullptr;
    if (N_LAUNCHES != PER_PHASE) bar = xcd_barrier_post((unsigned*)(ctl + CW_BAR) + args.li * 12288, MISC + 8);
#define GRID_BAR(seam) do { if (N_LAUNCHES == PER_PHASE) { if (tid == 0) __hip_atomic_store(ctl + CW_TMO, 0xBADBA0u | (unsigned)(seam), RLX_AGENT); } else { xcd_barrier(bar); } } while (0)
    const int lo = args.ph_lo, hi = args.ph_hi;
#ifndef PH_MASK
#define PH_MASK 0x7ff
#endif
#define IN(k) ((((PH_MASK) >> (k)) & 1) && lo <= (k) && (k) < hi)
#define BOTH(k) (IN(k) && IN((k) + 1))

    if (IN(0)) {
        kargp_t kp = KP();
        const float *cvec = kp->in[1], *w_ada = kp->in[2], *b_ada = kp->in[3], *w_in = kp->in[5], *w_out = kp->in[10], *w_group = kp->in[12], *w_expert = kp->in[14], *w_gate = kp->in[16], *w_up = kp->in[17], *w_down = kp->in[18];
        unsigned char* ws = kp->ws; float* MOD = (float*)(ws + WS_MOD);
        bf16 *WR = (bf16*)(ws + WS_WR), *WIN = (bf16*)(ws + WS_WIN), *WOUT = (bf16*)(ws + WS_WOUT); unsigned char *WGU = ws + WS_WGU, *WDN = ws + WS_WDN;
        for (int it = bx; it < (6 * DM) / 64; it += G) p0_mod_item(lds, cvec, w_ada, b_ada, MOD, it, tid);
        LAS float* scr = (LAS float*)(lds + RING_OFF + wave * 16384);
        constexpr int I_IN = 32 * 152, I_OUT = 32 * 64, I_G = 32 * 512, I_D = 32 * 512, NITEMS = I_IN + I_OUT + 2 * I_G + I_D;
        for (int it = gw; it < NITEMS; it += NGW) {
            int r = it;
            if (r < I_IN) { const int kb = r / 152, nb = r % 152; tr_item(w_in, NCOLS_IN, 64 * kb, 32 * nb, WIN + (size_t)(32 * nb) * DM, DM, scr, lane); continue; } r -= I_IN;
            if (r < I_OUT) { const int kb = r / 64, nb = r % 64; tr_item(w_out, DM, 64 * kb, 32 * nb, WOUT + (size_t)(32 * nb) * DM, DM, scr, lane); continue; } r -= I_OUT;
            if (r < 2 * I_G) { const int up = r >= I_G ? 1 : 0; r -= up * I_G; const int e = r / 512, q = r % 512, kb = q / 16, n0 = 32 * (q % 16), drow = 256 * (n0 >> 7) + (n0 & 127) + 128 * up;
                tr_item8((up ? w_up : w_gate) + (size_t)e * DM * DEXP, DEXP, 64 * kb, n0, WGU + ((size_t)e * 1024 + drow) * DM, DM, WSCALE_GU, scr, lane); continue; } r -= 2 * I_G;
            { const int e = r / 512, q = r % 512, kb = q / 64, n0 = 32 * (q % 64); tr_item8(w_down + (size_t)e * DEXP * DM, DM, 64 * kb, n0, WDN + ((size_t)e * DM + n0) * DEXP, DEXP, WSCALE_DN, scr, lane); }
        }
        for (int idx = gw * 64 + lane; idx < 256 * 256; idx += NGW * 64) {
            const int r = idx >> 8, k0 = (idx & 255) * 8; float v[8];
#pragma unroll
            for (int j = 0; j < 8; ++j) v[j] = r < 4 ? w_group[(k0 + j) * 4 + r] : (r < 36 ? w_expert[(k0 + j) * 32 + (r - 4)] : 0.f);
            v4u o; o.x = pk2(v[0], v[1]); o.y = pk2(v[2], v[3]); o.z = pk2(v[4], v[5]); o.w = pk2(v[6], v[7]); *(GAS v4u*)(WR + (size_t)r * DM + k0) = o;
        }
        if (BOTH(0)) GRID_BAR(0);
    }
    if (IN(1)) { kargp_t kp = KP(); norm_mod_rows(kp->in[0], kp->in[4], (const float*)WSP(kp, WS_MOD), 0, 1, (bf16*)WSP(kp, WS_XN), gw, NGW, lane); if (BOTH(1)) GRID_BAR(1); }
    if (IN(2)) {
        kargp_t kp = KP();
        pg8::Gemm g{WSP(kp, WS_XN), WSP(kp, WS_WIN), 2 * DM, 2 * DM}; pg8::StaticOrder S; S.init(M, NPROJ, G, bx);
        pg8::EpiProj E{(bf16*)WSP(kp, WS_PROJ), (float*)WSP(kp, WS_LOGF), kp->in[6], attn_body::C2};
        pg8::gemm_phase<pg8::EpiProj, pg8::StaticOrder, true>(lds + RING_OFF, g, S, E);
        if (BOTH(2)) GRID_BAR(2);
    }
    if (IN(3)) { kargp_t kp = KP(); for (int bh = bx; bh < 32; bh += G) scan_seq(lds, (const float*)WSP(kp, WS_LOGF), (float*)WSP(kp, WS_BIAS), bh, tid);
        knt_tiles((const bf16*)WSP(kp, WS_PROJ), (float*)WSP(kp, WS_KNT), gw, NGW, lane);
        if (BOTH(3)) GRID_BAR(3); }
    if (IN(4)) {
        kargp_t kp = KP();
        const attn_body::AttnArgs AT{(const attn_body::bf16*)WSP(kp, WS_PROJ), (attn_body::bf16*)WSP(kp, WS_OBUF), (const float*)WSP(kp, WS_BIAS), (const float*)WSP(kp, WS_KNT), kp->in[7], (unsigned*)WSP(kp, WS_CTL) + CW_QUEUE + 64 * kp->li};
        attn_body::attn_phase<8>((char*)lds_raw + RING_OFF, AT, vcu, G);
        if (BOTH(4)) GRID_BAR(4);
    }
    if (IN(5)) { kargp_t kp = KP(); onorm_rows((bf16*)WSP(kp, WS_OBUF), kp->in[8], kp->in[9], gw, NGW, lane); if (BOTH(5)) GRID_BAR(5); }
    if (IN(6)) {
        kargp_t kp = KP();
        pg8::Gemm g{WSP(kp, WS_OBUF), WSP(kp, WS_WOUT), 2 * DM, 2 * DM}; pg8::StaticOrder S; S.init(M, DM, G, bx);
        pg8::EpiResGate E{kp->in[0], kp->out, (const float*)WSP(kp, WS_MOD)};
        pg8::gemm_phase<pg8::EpiResGate, pg8::StaticOrder, true>(lds + RING_OFF, g, S, E);
        if (BOTH(6)) GRID_BAR(6);
    }
    if (IN(7)) { kargp_t kp = KP();
        norm_route_phase(lds, kp->out, kp->in[11], (const float*)WSP(kp, WS_MOD), WSP(kp, WS_XN8), (const bf16*)WSP(kp, WS_WR), kp->in[13], kp->in[15],
                         (gu32*)WSP(kp, WS_CTL) + CW_CNT, (int*)WSP(kp, WS_LIST), (int*)WSP(kp, WS_SLOT), (float*)WSP(kp, WS_EW), bx, G, tid);
        if (BOTH(7)) GRID_BAR(7); }
    if (IN(8)) {
        kargp_t kp = KP();
        moe_tables(lds + LDSCTL_OFF, (gu32*)WSP(kp, WS_CTL) + CW_CNT, tid);
        pg8::Gemm g{WSP(kp, WS_XN8), WSP(kp, WS_WGU), DM, DM}; pg8::GroupedOrder S{(const LAS int*)(lds + LDSCTL_OFF), (const LAS int*)(lds + LDSCTL_OFF + 160), (const int*)WSP(kp, WS_LIST), 4, G, bx};
        pg8::EpiSwiGLU E{WSP(kp, WS_HID), 1.0f / WSCALE_GU};
        pg8::gemm_phase<pg8::EpiSwiGLU, pg8::GroupedOrder, true, true>(lds + RING_OFF, g, S, E);
        if (BOTH(8)) GRID_BAR(8);
    }
    if (IN(9)) {
        kargp_t kp = KP();
        moe_tables(lds + LDSCTL_OFF, (gu32*)WSP(kp, WS_CTL) + CW_CNT, tid);
        pg8::Gemm g{WSP(kp, WS_HID), WSP(kp, WS_WDN), DEXP, DEXP}; pg8::GroupedOrder S{(const LAS int*)(lds + LDSCTL_OFF), (const LAS int*)(lds + LDSCTL_OFF + 160), nullptr, 8, G, bx};
        pg8::EpiDown E{(bf16*)WSP(kp, WS_YS), 1.0f / WSCALE_DN};
        pg8::gemm_phase<pg8::EpiDown, pg8::GroupedOrder, true, true>(lds + RING_OFF, g, S, E);
        if (BOTH(9)) GRID_BAR(9);
    }
    if (IN(10)) {
        kargp_t kp = KP();
        moe_tables(lds + LDSCTL_OFF, (gu32*)WSP(kp, WS_CTL) + CW_CNT, tid);
        const unsigned bad = __hip_atomic_load(ctl + CW_TMO, RLX_AGENT) | __hip_atomic_load((gu32*)((unsigned*)(ctl + CW_BAR) + args.li * 12288 + XB_TMO), RLX_AGENT);
        float* out = kp->out;
        final_rows(out, (const bf16*)WSP(kp, WS_YS), (const int*)WSP(kp, WS_SLOT), (const float*)WSP(kp, WS_EW), (const float*)WSP(kp, WS_MOD), kp->in[19], (const LAS int*)(lds + LDSCTL_OFF), gw, NGW, lane);
        if (bad && N_LAUNCHES != PER_PHASE) { const float qn = __builtin_nanf(""); for (int m = gw; m < M; m += NGW) out[(size_t)m * DM + lane] = qn; }
    }
#undef IN
#undef BOTH
}

extern "C" void kernel_launch(void* const* d_in, const int* in_sizes, int n_in, void* d_out, int out_size, void* d_ws, size_t ws_size, hipStream_t stream) {
    static int grid = 0;
    if (grid == 0) {
        if (n_in != 20 || in_sizes[0] != M * DM || out_size != M * DM || ws_size < WS_END) { fprintf(stderr, "kernel_launch: unexpected shapes or workspace (n_in %d, in0 %d, out %d, ws %zu < %zu); nothing launched\n", n_in, n_in > 0 ? in_sizes[0] : -1, out_size, ws_size, (size_t)WS_END); grid = -1; return; }
        int dev = 0, cus = 0, per_cu = 0;
        if (hipGetDevice(&dev) != hipSuccess || hipDeviceGetAttribute(&cus, hipDeviceAttributeMultiprocessorCount, dev) != hipSuccess) { fprintf(stderr, "kernel_launch: device query failed\n"); grid = -1; return; }
        if (hipFuncSetAttribute((const void*)fwd_kernel, hipFuncAttributeMaxDynamicSharedMemorySize, LDS_BYTES) != hipSuccess) { fprintf(stderr, "kernel_launch: hipFuncSetAttribute failed\n"); grid = -1; return; }
        if (hipOccupancyMaxActiveBlocksPerMultiprocessor(&per_cu, (const void*)fwd_kernel, NWAVES * 64, LDS_BYTES) != hipSuccess || per_cu < 1) fprintf(stderr, "kernel_launch: note: occupancy query reports %d workgroups per CU\n", per_cu);
        (void)hipGetLastError();
        grid = cus;
    }
    if (grid < 0) return;
    if (hipMemsetAsync((char*)d_ws + WS_CTL, 0, CTL_ZERO_BYTES, stream) != hipSuccess) { fprintf(stderr, "kernel_launch: hipMemsetAsync failed\n"); return; }
    Args a{};
    for (int i = 0; i < 20; ++i) a.in[i] = (const float*)d_in[i];
    a.out = (float*)d_out; a.ws = (unsigned char*)d_ws;
#if defined(PROBE_A) && defined(PROBE_B)
    const int nl = 2;
#else
    const int nl = N_LAUNCHES;
#endif
    for (int li = 0; li < nl; ++li) {
        a.ph_lo = (N_LAUNCHES == PER_PHASE) ? li : 0; a.ph_hi = (N_LAUNCHES == PER_PHASE) ? li + 1 : PER_PHASE; a.li = (N_LAUNCHES == PER_PHASE) ? 0 : li;
#if defined(PROBE_A) && defined(PROBE_B)
        a.ph_lo = li ? PROBE_A : 0; a.ph_hi = li ? PER_PHASE : PROBE_B;
#endif
        hipLaunchKernelGGL(fwd_kernel, dim3(grid), dim3(NWAVES * 64), LDS_BYTES, stream, a);
        const hipError_t le = hipPeekAtLastError();
        if (le != hipSuccess) { fprintf(stderr, "kernel_launch: launch %d failed: %s\n", li, hipGetErrorName(le)); break; }
    }
}
```
